# Optimizing an MI355X kernel written in HIP

```python
import jax, jax.numpy as jnp
from jax import lax
import numpy as np

D_MODEL = 1024
BATCH = 32
SEQ = 2048
DEPTH = 1

ATTN_HEAD_DIM = 64
N_Q_HEADS = D_MODEL // 128
N_KV_HEADS = 2
ATTN_WIDTH = N_Q_HEADS * ATTN_HEAD_DIM
KV_WIDTH = N_KV_HEADS * ATTN_HEAD_DIM
WINDOW = 128
ROPE_THETA = 10000.0
HGRN_EXPAND = 128
HGRN_HEADS = (D_MODEL // 2) // HGRN_EXPAND
HGRN_WIDTH = HGRN_HEADS * HGRN_EXPAND
HGRN_HEAD_V = 128
HGRN_V_WIDTH = HGRN_HEADS * HGRN_HEAD_V
HGRN_CHUNK = 64
SPLITS = [ATTN_WIDTH, KV_WIDTH, KV_WIDTH, HGRN_WIDTH, HGRN_WIDTH, HGRN_V_WIDTH, HGRN_V_WIDTH, D_MODEL, D_MODEL]
IN_COLS = sum(SPLITS)
SPLIT_IDX = list(np.cumsum(SPLITS)[:-1])
N_EXPERTS = 32
TOP_K = 4
D_EXPERT = D_MODEL
SWIGLU_ALPHA = 1.702
SWIGLU_LIMIT = 7.0
MOE_BLOCK = 512
NORM_EPS = 1e-5

kernel_name = 'hybrid_swa_hgrn2_moe_block'


def rms_norm(x, g):
    x32 = x.astype(jnp.float32)
    y = x32 * lax.rsqrt(jnp.mean(x32 * x32, axis=-1, keepdims=True) + NORM_EPS)
    return (y * g.astype(jnp.float32)).astype(x.dtype)


def rotary(x, positions):
    hd = x.shape[-1]
    half = hd // 2
    inv_freq = ROPE_THETA ** (-(jnp.arange(half, dtype=jnp.float32) * 2.0 / hd))
    ang = positions.astype(jnp.float32)[:, None] * inv_freq[None, :]
    cos = jnp.cos(ang)[None, :, None, :]
    sin = jnp.sin(ang)[None, :, None, :]
    x32 = x.astype(jnp.float32)
    x1, x2 = x32[..., :half], x32[..., half:]
    out = jnp.concatenate([x1 * cos - x2 * sin, x2 * cos + x1 * sin], axis=-1)
    return out.astype(x.dtype)


def sliding_window_attention(q, k, v, sinks):
    B, S = q.shape[0], q.shape[1]
    nB = S // WINDOW
    G = N_Q_HEADS // N_KV_HEADS
    hd = ATTN_HEAD_DIM
    qb = q.reshape(B, nB, WINDOW, N_KV_HEADS, G, hd)

    def band(t):
        tp = jnp.pad(t, ((0, 0), (WINDOW, 0), (0, 0), (0, 0))).reshape(B, nB + 1, WINDOW, N_KV_HEADS, hd)
        return jnp.concatenate([tp[:, :-1], tp[:, 1:]], axis=2)

    kb, vb = band(k), band(v)
    s = jnp.einsum('bnqhgd,bnkhd->bnhgqk', qb, kb, preferred_element_type=jnp.float32) * (hd ** -0.5)
    qi = jnp.arange(WINDOW)[:, None]
    kj = jnp.arange(2 * WINDOW)[None, :]
    band_mask = (kj > qi) & (kj <= qi + WINDOW)
    first_ok = (jnp.arange(nB)[:, None, None] > 0) | (kj[None] >= WINDOW)
    mask = (band_mask[None] & first_ok)[None, :, None, None]
    s = jnp.where(mask, s, -jnp.inf)
    sink = sinks.astype(jnp.float32).reshape(N_KV_HEADS, G)[None, None, :, :, None]
    m = jnp.maximum(jnp.max(s, axis=-1), sink)
    p = jnp.exp(s - m[..., None])
    denom = jnp.sum(p, axis=-1) + jnp.exp(sink - m)
    p = p / denom[..., None]
    o = jnp.einsum('bnhgqk,bnkhd->bnqhgd', p.astype(v.dtype), vb)
    return o.reshape(B, S, ATTN_WIDTH)


def hgrn2_recurrence(q, k, v, log_f):
    B, S, H, dk = q.shape
    dv = v.shape[-1]
    C = HGRN_CHUNK
    nC = S // C

    def chunks(t):
        return t.reshape(B, nC, C, H, t.shape[-1]).transpose(1, 0, 3, 2, 4)

    causal = jnp.tril(jnp.ones((C, C), dtype=bool))[None, None, :, :, None]

    def step(state, inp):
        qc, kc, vc, gc = inp
        Gc = jnp.cumsum(gc, axis=2)
        inter = jnp.einsum('bhtk,bhkv->bhtv', qc * jnp.exp(Gc), state)
        rel = jnp.where(causal, Gc[:, :, :, None, :] - Gc[:, :, None, :, :], -jnp.inf)
        attn = jnp.einsum('bhtk,bhsk,bhtsk->bhts', qc, kc, jnp.exp(rel))
        intra = jnp.einsum('bhts,bhsv->bhtv', attn, vc)
        G_last = Gc[:, :, -1:, :]
        new_state = jnp.exp(G_last[:, :, 0, :])[..., None] * state + jnp.einsum(
            'bhsk,bhsv->bhkv', kc * jnp.exp(G_last - Gc), vc)
        return new_state, inter + intra

    state0 = jnp.zeros((B, H, dk, dv), jnp.float32)
    _, o = lax.scan(step, state0, (chunks(q), chunks(k), chunks(v), chunks(log_f)))
    return o.transpose(1, 0, 3, 2, 4).reshape(B, S, H, dv)


def hybrid_mixer(u, w_in, b_in, sinks, lb, hg_norm_g, w_up_attn, w_up_hgrn, w_out):
    B, S, _ = u.shape
    z = u @ w_in + b_in
    zq, zk, zv, hq, hf, hi, hg, ga, gh = jnp.split(z, SPLIT_IDX, axis=-1)
    pos = jnp.arange(S)
    q = rotary(zq.reshape(B, S, N_Q_HEADS, ATTN_HEAD_DIM), pos)
    k = rotary(zk.reshape(B, S, N_KV_HEADS, ATTN_HEAD_DIM), pos)
    v = zv.reshape(B, S, N_KV_HEADS, ATTN_HEAD_DIM)
    y_attn = sliding_window_attention(q, k, v, sinks)
    f = lb + (1.0 - lb) * jax.nn.sigmoid(hf.astype(jnp.float32))
    kk = 1.0 - f
    log_f = jnp.log(f)
    shp_k = (B, S, HGRN_HEADS, HGRN_EXPAND)
    o = hgrn2_recurrence(hq.astype(jnp.float32).reshape(shp_k), kk.reshape(shp_k),
                         hi.astype(jnp.float32).reshape(B, S, HGRN_HEADS, HGRN_HEAD_V),
                         log_f.reshape(shp_k))
    o = o * lax.rsqrt(jnp.mean(o * o, axis=-1, keepdims=True) + NORM_EPS)
    o = o.reshape(B, S, HGRN_V_WIDTH) * hg_norm_g.astype(jnp.float32)
    y_hgrn = (o * jax.nn.silu(hg.astype(jnp.float32))).astype(u.dtype)
    merged = jax.nn.sigmoid(ga) * (y_attn @ w_up_attn) + jax.nn.sigmoid(gh) * (y_hgrn @ w_up_hgrn)
    return merged @ w_out


def moe_ffn(u, w_router, b_router, w1, b1, w2, b2):
    B, S, D = u.shape
    xt = u.reshape(B * S, D)
    N = B * S
    A = N * TOP_K
    logits = (xt @ w_router + b_router).astype(jnp.float32)
    top_val, top_idx = lax.top_k(logits, TOP_K)
    gates = jax.nn.softmax(top_val, axis=-1)
    e_flat = top_idx.reshape(-1).astype(jnp.int32)
    tok_flat = jnp.arange(A, dtype=jnp.int32) // TOP_K
    w_flat = gates.reshape(-1)
    order = jnp.argsort(e_flat)
    e_sorted = e_flat[order]
    counts = jnp.bincount(e_flat, length=N_EXPERTS)
    starts = jnp.cumsum(counts) - counts
    padded = ((counts + MOE_BLOCK - 1) // MOE_BLOCK) * MOE_BLOCK
    pad_ends = jnp.cumsum(padded)
    pad_starts = pad_ends - padded
    dest = pad_starts[e_sorted] + (jnp.arange(A, dtype=jnp.int32) - starts[e_sorted])
    n_blocks = -(-A // MOE_BLOCK) + N_EXPERTS
    P = n_blocks * MOE_BLOCK
    row_tok = jnp.zeros((P,), jnp.int32).at[dest].set(tok_flat[order])
    row_w = jnp.zeros((P,), jnp.float32).at[dest].set(w_flat[order])
    blk_e = jnp.minimum(jnp.searchsorted(pad_ends, jnp.arange(n_blocks) * MOE_BLOCK, side='right'),
                        N_EXPERTS - 1).astype(jnp.int32)

    def block(acc, inp):
        tok, w, e = inp
        h = xt[tok] @ w1[e] + b1[e]
        glu = jnp.minimum(h[:, :D_EXPERT], SWIGLU_LIMIT)
        lin = jnp.clip(h[:, D_EXPERT:], -SWIGLU_LIMIT, SWIGLU_LIMIT)
        act = glu * jax.nn.sigmoid(SWIGLU_ALPHA * glu) * (lin + 1.0)
        y = act @ w2[e] + b2[e]
        return acc.at[tok].add(y.astype(jnp.float32) * w[:, None]), None

    acc0 = jnp.zeros((N, D), jnp.float32)
    out, _ = lax.scan(block, acc0, (row_tok.reshape(n_blocks, MOE_BLOCK),
                                    row_w.reshape(n_blocks, MOE_BLOCK), blk_e))
    return out.astype(u.dtype).reshape(B, S, D)


def setup_inputs(seed: int = 0) -> dict:
    key = jax.random.key(seed)
    ks = jax.random.split(key, 20)
    f32 = jnp.float32

    def nrm(k, shape, scale):
        return jax.random.normal(k, shape, f32) * scale

    return {
        'x': nrm(ks[0], (BATCH, SEQ, D_MODEL), 1.0),
        'norm_mix_g': 1.0 + nrm(ks[1], (DEPTH, D_MODEL), 0.02),
        'w_in': nrm(ks[2], (DEPTH, D_MODEL, IN_COLS), D_MODEL ** -0.5),
        'b_in': nrm(ks[3], (DEPTH, IN_COLS), 0.02),
        'attn_sinks': nrm(ks[4], (DEPTH, N_Q_HEADS), 0.5),
        'hgrn_lb': nrm(ks[5], (DEPTH + 1, HGRN_WIDTH), 0.5),
        'hgrn_norm_g': 1.0 + nrm(ks[6], (DEPTH, HGRN_V_WIDTH), 0.02),
        'w_up_attn': nrm(ks[7], (DEPTH, ATTN_WIDTH, D_MODEL), ATTN_WIDTH ** -0.5),
        'w_up_hgrn': nrm(ks[8], (DEPTH, HGRN_V_WIDTH, D_MODEL), HGRN_V_WIDTH ** -0.5),
        'w_out': nrm(ks[9], (DEPTH, D_MODEL, D_MODEL), D_MODEL ** -0.5),
        'norm_ffn_g': 1.0 + nrm(ks[10], (DEPTH, D_MODEL), 0.02),
        'w_router': nrm(ks[11], (DEPTH, D_MODEL, N_EXPERTS), D_MODEL ** -0.5),
        'b_router': nrm(ks[12], (DEPTH, N_EXPERTS), 0.01),
        'w_moe1': nrm(ks[13], (DEPTH, N_EXPERTS, D_MODEL, 2 * D_EXPERT), D_MODEL ** -0.5),
        'b_moe1': nrm(ks[14], (DEPTH, N_EXPERTS, 2 * D_EXPERT), 0.02),
        'w_moe2': nrm(ks[15], (DEPTH, N_EXPERTS, D_EXPERT, D_MODEL), D_EXPERT ** -0.5),
        'b_moe2': nrm(ks[16], (DEPTH, N_EXPERTS, D_MODEL), 0.02),
        'norm_final_g': 1.0 + nrm(ks[17], (D_MODEL,), 0.02),
    }


def reference(x, norm_mix_g, w_in, b_in, attn_sinks, hgrn_lb, hgrn_norm_g, w_up_attn, w_up_hgrn,
              w_out, norm_ffn_g, w_router, b_router, w_moe1, b_moe1, w_moe2, b_moe2, norm_final_g):
    lb_all = jnp.cumsum(jax.nn.softmax(hgrn_lb.astype(jnp.float32), axis=0), axis=0)
    h = x
    for l in range(DEPTH):
        h = h + hybrid_mixer(rms_norm(h, norm_mix_g[l]), w_in[l], b_in[l], attn_sinks[l], lb_all[l],
                             hgrn_norm_g[l], w_up_attn[l], w_up_hgrn[l], w_out[l])
        h = h + moe_ffn(rms_norm(h, norm_ffn_g[l]), w_router[l], b_router[l], w_moe1[l], b_moe1[l],
                        w_moe2[l], b_moe2[l])
    return rms_norm(h, norm_final_g)
```

```cpp
#include <hip/hip_runtime.h>
#include <cstdio>
#include <cstdint>
namespace pg8 {
#define PG8_LAS __attribute__((address_space(3)))
typedef unsigned short bf16_t;
typedef short bf16x8 __attribute__((ext_vector_type(8)));
typedef float f32x4 __attribute__((ext_vector_type(4)));
typedef unsigned u32x4 __attribute__((ext_vector_type(4)));
constexpr int BM = 256, BK = 64, HALF = 128, HTB = HALF * BK * 2  , STAGE_BYTES = 8 * HTB, NXCD = 8, WGM = 8;

__host__ __device__ __forceinline__ int lds_byte(int r, int c) { const int st = (r >> 4) * 2 + (c >> 5), rr = r & 15, cc = c & 31, ob = rr * 64 + cc * 2; return st * 1024 + (ob ^ (((ob >> 9) & 1) << 5)); }
__host__ __device__ __forceinline__ void stage_rc(int b, int& R, int& C) { const int st = b / 1024, sb = b % 1024, swz = sb ^ (((sb >> 9) & 1) << 5); R = (st >> 1) * 16 + swz / 64; C = (st & 1) * 32 + (swz % 64) / 2; }
__host__ __device__ __forceinline__ int perm32(int rho) { const int n = rho >> 4, i = rho & 15; return 8 * (i >> 2) + 4 * n + (i & 3); }

struct Unit { int pm, pn; };
struct Gemm { const bf16_t* A; const bf16_t* Bt; int M, N, K; };

struct StaticOrder {
    int nM, nN, nwg, G, c;
    __host__ __device__ void init(int M, int N, int G_, int c_) { nM = M / BM; nN = N / BM; nwg = nM * nN; G = G_; c = c_; }
    __host__ __device__ bool next(int i, Unit& u) const {
        const long L = (long)i * G + c; if (L >= nwg) return false;
        int wgid = (int)L; { const int q = nwg / NXCD, r = nwg % NXCD, xcd = wgid % NXCD, off = wgid / NXCD; wgid = (xcd < r ? xcd * (q + 1) : r * (q + 1) + (xcd - r) * q) + off; }
        const int nig = WGM * nN, gid = wgid / nig, fm = gid * WGM, gsz = (nM - fm) < WGM ? (nM - fm) : WGM;
        u.pm = fm + ((wgid % nig) % gsz); u.pn = (wgid % nig) / gsz; return true;
    }
    __device__ __forceinline__ void a_ready(const Unit&) const {}
    __device__ __forceinline__ void done(const Unit&) const {}
};
__device__ __forceinline__ unsigned cvt_pk_bf16(float lo, float hi) { unsigned r; asm volatile("v_cvt_pk_bf16_f32 %0, %1, %2" : "=v"(r) : "v"(lo), "v"(hi)); return r; }
template <class Epi, class Sched, bool ALIGN_EPI = false, bool SP2 = false>
__device__ __forceinline__ void gemm_phase(PG8_LAS unsigned char* lds, const Gemm g, const Sched& S, const Epi& E) {
    const int tid = threadIdx.x, wid = __builtin_amdgcn_readfirstlane(tid >> 6), lane = tid & 63, wr = wid >> 2, wc = wid & 3, fr = lane & 15, fq = lane >> 4;
    const int K = g.K, nt = K / BK;
    unsigned voffA[2], voffB[2];
#pragma unroll
    for (int i = 0; i < 2; ++i) { int R, C; stage_rc(tid * 16 + i * 8192, R, C); const int Rb = Epi::PERM ? ((R & ~31) + perm32(R & 31)) : R;
        voffA[i] = (unsigned)(R * K + C) * 2u; voffB[i] = (unsigned)(Rb * K + C) * 2u; }
    const size_t kstep = (size_t)(BK * 2);
    const size_t hstep = (size_t)HALF * K * 2;
    const size_t tstep = 2 * hstep;
    const unsigned ldsw = (unsigned)wid * 1024u;
    const int aoff = lds_byte(wr * 64 + fr, fq * 8), boff = lds_byte(wc * 32 + fr, fq * 8);
#define PG8_SA(b, h) (((b) * 2 + (h)) * HTB)
#define PG8_SB(b, h) ((4 + (b) * 2 + (h)) * HTB)
#define PG8_STAGE(bufoff, gbase, voff) do { _Pragma("unroll") for (int _i = 0; _i < 2; ++_i) \
        __builtin_amdgcn_global_load_lds((const unsigned*)((const char*)(gbase) + (voff)[_i]), (PG8_LAS unsigned*)(lds + (bufoff) + ldsw + _i * 8192), 16, 0, 0); } while (0)
#define PG8_LDA(dst, b, h) do { _Pragma("unroll") for (int m = 0; m < 4; ++m) _Pragma("unroll") for (int k = 0; k < 2; ++k) dst[m][k] = *(const PG8_LAS bf16x8*)(lds + PG8_SA(b, h) + aoff + m * 2048 + k * 1024); } while (0)
#define PG8_LDB(dst, b, h) do { _Pragma("unroll") for (int n = 0; n < 2; ++n) _Pragma("unroll") for (int k = 0; k < 2; ++k) dst[n][k] = *(const PG8_LAS bf16x8*)(lds + PG8_SB(b, h) + boff + n * 2048 + k * 1024); } while (0)
#define PG8_MMA(ai, bj, At, Bt) do { __builtin_amdgcn_s_setprio(1); _Pragma("unroll") for (int m = 0; m < 4; ++m) _Pragma("unroll") for (int n = 0; n < 2; ++n) _Pragma("unroll") for (int k = 0; k < 2; ++k) \
        acc[ai][bj][m][n] = __builtin_amdgcn_mfma_f32_16x16x32_bf16(Bt[n][k], At[m][k], acc[ai][bj][m][n], 0, 0, 0); __builtin_amdgcn_s_setprio(0); } while (0)
#define PG8_WAIT_V(n) asm volatile("s_waitcnt vmcnt(" #n ")" ::: "memory")
#define PG8_WAIT_L(n) asm volatile("s_waitcnt lgkmcnt(" #n ")" ::: "memory")
#define PG8_BAR __builtin_amdgcn_s_barrier()
#define PG8_SCHED __builtin_amdgcn_sched_barrier(0)
    Unit cur, nxt; int ui = 0;
    if (!S.next(0, cur)) return;
    f32x4 acc[2][2][4][2];
#pragma unroll
    for (int a = 0; a < 2; ++a)
#pragma unroll
        for (int b = 0; b < 2; ++b)
#pragma unroll
            for (int m = 0; m < 4; ++m)
#pragma unroll
                for (int n = 0; n < 2; ++n) acc[a][b][m][n] = (f32x4){0.f, 0.f, 0.f, 0.f};
    bf16x8 At[4][2], B0[2][2], B1[2][2];
    const char* cA = (const char*)g.A + (size_t)cur.pm * tstep; const char* cB = (const char*)g.Bt + (size_t)cur.pn * tstep;
    S.a_ready(cur);
    if constexpr (SP2) {
        PG8_STAGE(PG8_SB(0, 0), cB, voffB); PG8_STAGE(PG8_SB(0, 1), cB + hstep, voffB); PG8_STAGE(PG8_SA(0, 0), cA, voffA); PG8_STAGE(PG8_SA(0, 1), cA + hstep, voffA);
        if (wr == 1) PG8_BAR;
        PG8_WAIT_V(2); PG8_BAR;
        PG8_STAGE(PG8_SB(1, 0), cB + kstep, voffB); PG8_STAGE(PG8_SA(1, 0), cA + kstep, voffA); PG8_STAGE(PG8_SB(1, 1), cB + hstep + kstep, voffB);
        PG8_WAIT_V(6); PG8_BAR;
    } else {
        PG8_STAGE(PG8_SB(0, 0), cB, voffB); PG8_STAGE(PG8_SA(0, 0), cA, voffA); PG8_STAGE(PG8_SB(0, 1), cB + hstep, voffB); PG8_STAGE(PG8_SA(0, 1), cA + hstep, voffA);
        if (wr == 1) PG8_BAR;
        PG8_WAIT_V(4); PG8_BAR;
        PG8_STAGE(PG8_SB(1, 0), cB + kstep, voffB); PG8_STAGE(PG8_SA(1, 0), cA + kstep, voffA); PG8_STAGE(PG8_SB(1, 1), cB + hstep + kstep, voffB);
        PG8_WAIT_V(6); PG8_BAR;
    }
    for (;;) {
        const bool has_next = S.next(ui + 1, nxt);
        const char* nA = has_next ? (const char*)g.A + (size_t)nxt.pm * tstep : cA; const char* nB = has_next ? (const char*)g.Bt + (size_t)nxt.pn * tstep : cB;
        for (int t = 0; t < nt; t += 2) {
            const bool last = (t == nt - 2);
            const char* a1 = cA + (size_t)(t + 1) * kstep;
            const char* a2 = last ? nA : cA + (size_t)(t + 2) * kstep; const char* b2 = last ? nB : cB + (size_t)(t + 2) * kstep;
            const char* a3 = a2 + kstep; const char* b3 = b2 + kstep;
            if (last && has_next) S.a_ready(nxt);
            if constexpr (SP2) {
            PG8_LDB(B0, 0, 0); PG8_LDB(B1, 0, 1); PG8_SCHED; PG8_LDA(At, 0, 0); PG8_STAGE(PG8_SA(1, 1), a1 + hstep, voffA);
            PG8_WAIT_V(8); PG8_WAIT_L(0); PG8_BAR; PG8_MMA(0, 0, At, B0); PG8_MMA(0, 1, At, B1); PG8_BAR; PG8_SCHED;
            PG8_LDA(At, 0, 1); PG8_STAGE(PG8_SB(0, 0), b2, voffB); PG8_STAGE(PG8_SB(0, 1), b2 + hstep, voffB); PG8_STAGE(PG8_SA(0, 0), a2, voffA);
            PG8_WAIT_V(8); PG8_WAIT_L(0); PG8_BAR; PG8_MMA(1, 0, At, B0); PG8_MMA(1, 1, At, B1); PG8_BAR; PG8_SCHED;
            PG8_LDB(B0, 1, 0); PG8_LDB(B1, 1, 1); PG8_SCHED; PG8_LDA(At, 1, 0); PG8_STAGE(PG8_SA(0, 1), a2 + hstep, voffA);
            PG8_WAIT_V(8); PG8_WAIT_L(0); PG8_BAR; PG8_MMA(0, 0, At, B0); PG8_MMA(0, 1, At, B1); PG8_BAR; PG8_SCHED;
            PG8_LDA(At, 1, 1); PG8_STAGE(PG8_SB(1, 0), b3, voffB); PG8_STAGE(PG8_SB(1, 1), b3 + hstep, voffB); PG8_STAGE(PG8_SA(1, 0), a3, voffA);
            PG8_WAIT_V(8); PG8_WAIT_L(0); PG8_BAR; PG8_MMA(1, 0, At, B0); PG8_MMA(1, 1, At, B1); PG8_BAR; PG8_SCHED;
            } else {
            PG8_LDB(B0, 0, 0); PG8_SCHED; PG8_LDA(At, 0, 0); PG8_STAGE(PG8_SA(1, 1), a1 + hstep, voffA);
            PG8_WAIT_L(8); PG8_BAR; PG8_WAIT_L(0); PG8_MMA(0, 0, At, B0); PG8_BAR; PG8_SCHED;
            PG8_LDB(B1, 0, 1); PG8_STAGE(PG8_SB(0, 0), b2, voffB);
            PG8_BAR; PG8_WAIT_L(0); PG8_MMA(0, 1, At, B1); PG8_BAR;
            PG8_LDA(At, 0, 1); PG8_STAGE(PG8_SA(0, 0), a2, voffA);
            PG8_BAR; PG8_WAIT_L(0); PG8_MMA(1, 0, At, B0); PG8_BAR; PG8_SCHED;
            PG8_STAGE(PG8_SB(0, 1), b2 + hstep, voffB);
            PG8_WAIT_V(6); PG8_BAR; PG8_MMA(1, 1, At, B1); PG8_BAR;
            PG8_LDB(B0, 1, 0); PG8_SCHED; PG8_LDA(At, 1, 0); PG8_STAGE(PG8_SA(0, 1), a2 + hstep, voffA);
            PG8_WAIT_L(8); PG8_BAR; PG8_WAIT_L(0); PG8_MMA(0, 0, At, B0); PG8_BAR; PG8_SCHED;
            PG8_LDB(B1, 1, 1); PG8_STAGE(PG8_SB(1, 0), b3, voffB);
            PG8_BAR; PG8_WAIT_L(0); PG8_MMA(0, 1, At, B1); PG8_BAR;
            PG8_LDA(At, 1, 1); PG8_STAGE(PG8_SA(1, 0), a3, voffA);
            PG8_BAR; PG8_WAIT_L(0); PG8_MMA(1, 0, At, B0); PG8_BAR; PG8_SCHED;
            PG8_STAGE(PG8_SB(1, 1), b3 + hstep, voffB);
            PG8_WAIT_V(6); PG8_BAR; PG8_MMA(1, 1, At, B1); PG8_BAR;
            }
        }
        if constexpr (ALIGN_EPI) { if (wr == 0) PG8_BAR; }
        if constexpr (!Epi::AFTER_DRAIN) { E(acc, cur, wr, wc, fr, fq); S.done(cur); }
        if (!has_next) break;
#pragma unroll
        for (int a = 0; a < 2; ++a)
#pragma unroll
            for (int b = 0; b < 2; ++b)
#pragma unroll
                for (int m = 0; m < 4; ++m)
#pragma unroll
                    for (int n = 0; n < 2; ++n) acc[a][b][m][n] = (f32x4){0.f, 0.f, 0.f, 0.f};
        cur = nxt; cA = nA; cB = nB; ++ui;
        if constexpr (ALIGN_EPI) { if (wr == 1) PG8_BAR; }
    }
    PG8_WAIT_V(0);
    if constexpr (!ALIGN_EPI) { if (wr == 0) PG8_BAR; }
    PG8_BAR;
    if constexpr (Epi::AFTER_DRAIN) { E.fused(acc, cur, wr, wc, fr, fq, lds, wid, lane); S.done(cur); }
#undef PG8_SA
#undef PG8_SB
#undef PG8_STAGE
#undef PG8_LDA
#undef PG8_LDB
#undef PG8_MMA
#undef PG8_WAIT_V
#undef PG8_WAIT_L
#undef PG8_BAR
#undef PG8_SCHED
}
}
#define GAS __attribute__((address_space(1)))
#define LAS __attribute__((address_space(3)))
typedef unsigned short bf16;
typedef unsigned v4u __attribute__((ext_vector_type(4)));
typedef float f32x4 __attribute__((ext_vector_type(4)));
typedef short bf16x8 __attribute__((ext_vector_type(8)));
typedef GAS unsigned gu32;
typedef GAS unsigned long long gu64;
#define RLX_AGENT __ATOMIC_RELAXED, __HIP_MEMORY_SCOPE_AGENT
#define LDS_WAIT() asm volatile("s_waitcnt lgkmcnt(0)" ::: "memory")
#define VM_WAIT() asm volatile("s_waitcnt vmcnt(0)" ::: "memory")
__device__ __forceinline__ unsigned long long rt() { return __builtin_amdgcn_s_memrealtime(); }
__device__ __forceinline__ unsigned f2bf(float f) { unsigned u = __builtin_bit_cast(unsigned, f); return (u + 0x7fffu + ((u >> 16) & 1u)) >> 16; }
__device__ __forceinline__ unsigned pk2(float lo, float hi) { return f2bf(lo) | (f2bf(hi) << 16); }
#define XB_TMO      128
#define XB_XCNT(j)  (256  + 64 * (j))
#define XB_XSUB(j)  (1280 + 64 * (j))
#define XB_XGEN(j)  (2304 + 64 * (j))
#define XB_TOP      3328
#define XB_TOPGEN   3392
#define XCD_BAR_WORDS 3456
#define XB_SPIN_CAP (1u << 18)

__device__ __forceinline__ unsigned xb_ld(unsigned* p)              { return __hip_atomic_load(p, __ATOMIC_RELAXED, __HIP_MEMORY_SCOPE_AGENT); }
__device__ __forceinline__ unsigned xb_add(unsigned* p, unsigned v) { return __hip_atomic_fetch_add(p, v, __ATOMIC_RELAXED, __HIP_MEMORY_SCOPE_AGENT); }
__device__ __forceinline__ unsigned xb_xcc_id() { return (unsigned)__builtin_amdgcn_s_getreg((3 << 11) | 20) & 0xFu; }
#define XB_SPIN(cond, bar) do { unsigned _sp = 0; while (cond) { __builtin_amdgcn_s_sleep(1); \
    if ((++_sp & 255u) == 0u) { if (xb_ld(&(bar)[XB_TMO])) break; if (_sp > XB_SPIN_CAP) { atomicAdd(&(bar)[XB_TMO], 1u); break; } } } } while (0)

struct XcdBarrier {
    unsigned* bar; unsigned x;
    volatile LAS unsigned* st;
};

__device__ __forceinline__ XcdBarrier xcd_barrier_post(unsigned* bar, volatile LAS unsigned* st) {
    XcdBarrier b; b.bar = bar; b.x = xb_xcc_id(); b.st = st;
    if (threadIdx.x == 0) (void)xb_add(&bar[XB_XCNT(b.x)], 1u);
    return b;
}
__device__ __forceinline__ void xcd_barrier_complete(unsigned* bar, unsigned x, unsigned& nloc, unsigned& nx) {
    const unsigned G = gridDim.x * gridDim.y * gridDim.z;
    unsigned sum, cnt, mine, sp = 0u;
    for (;;) {
        sum = 0u; cnt = 0u; mine = 0u;
#pragma unroll
        for (unsigned j = 0; j < 16; ++j) { const unsigned c = xb_ld(&bar[XB_XCNT(j)]); sum += c; cnt += (c > 0u) ? 1u : 0u; mine = (j == x) ? c : mine; }
        if (sum == G) break;
        __builtin_amdgcn_s_sleep(1);
        if ((++sp & 255u) == 0u) { if (xb_ld(&bar[XB_TMO])) break; if (sp > XB_SPIN_CAP) { atomicAdd(&bar[XB_TMO], 1u); break; } }
    }
    nloc = mine > 0u ? mine : 1u; nx = cnt > 0u ? cnt : 1u;
}

__device__ __forceinline__ void xcd_barrier(const XcdBarrier& b) {
    asm volatile("s_waitcnt vmcnt(0)" ::: "memory");
    __syncthreads();
    if (threadIdx.x == 0) {
        unsigned* bar = b.bar;
        __builtin_amdgcn_s_waitcnt(0);
        unsigned nloc = b.st[0], nx = b.st[1];
        if (nloc == 0u) { xcd_barrier_complete(bar, b.x, nloc, nx); b.st[0] = nloc; b.st[1] = nx; }
        const unsigned old = xb_add(&bar[XB_XSUB(b.x)], 1u);
        const unsigned gen = old / nloc;
        if (old + 1u == (gen + 1u) * nloc) {
            __builtin_amdgcn_fence(__ATOMIC_RELEASE, "agent");
            asm volatile("s_waitcnt vmcnt(0)" ::: "memory");
            const unsigned og = xb_add(&bar[XB_TOP], 1u);
            const unsigned tg = og / nx;
            if (og + 1u == (tg + 1u) * nx) xb_add(&bar[XB_TOPGEN], 1u);
            else XB_SPIN(xb_ld(&bar[XB_TOPGEN]) == tg, bar);
            __builtin_amdgcn_fence(__ATOMIC_ACQUIRE, "agent");
            xb_add(&bar[XB_XGEN(b.x)], 1u);
            asm volatile("s_waitcnt vmcnt(0)" ::: "memory");
        } else {
            XB_SPIN(xb_ld(&bar[XB_XGEN(b.x)]) == gen, bar);
            __builtin_amdgcn_fence(__ATOMIC_ACQUIRE, "agent");
            asm volatile("s_waitcnt vmcnt(0)" ::: "memory");
        }
    }
    __syncthreads();
}

constexpr int NWAVES = 8;
constexpr int NTOK = 65536, DM = 1024, SEQ = 2048, NBATCH = 32, INC = 4864;
constexpr int NEXP = 32, TOPK = 4;
constexpr float NORM_EPS = 1e-5f;
constexpr float LOG2E = 1.4426950408889634f;
constexpr float QSCALE = 0.125f * LOG2E;
constexpr int HALF_TOK = NTOK / 2;
constexpr int HALF_ROWS = HALF_TOK * TOPK + NEXP * 256;

constexpr size_t MiB = 1u << 20;
constexpr size_t WS_CTL = 0, CTL_ZERO_BYTES = 1 * MiB;
constexpr int CW_BAR = 4096;
constexpr size_t WS_WIN = 2 * MiB;
constexpr size_t WS_WUA = 12 * MiB;
constexpr size_t WS_WUH = 13 * MiB;
constexpr size_t WS_WOUT = 14 * MiB;
constexpr size_t WS_W1 = 16 * MiB;
constexpr size_t WS_W2 = 144 * MiB;
constexpr size_t WS_ROPE = 208 * MiB;
constexpr size_t WS_WRT = 208 * MiB + 512 * 1024;
constexpr size_t WS_TOPE = 209 * MiB;
constexpr size_t WS_GATE = 210 * MiB;
constexpr size_t WS_LRANK = 211 * MiB;
constexpr size_t WS_ROWOF = 212 * MiB;
constexpr size_t WS_RS = 213 * MiB;
constexpr size_t WS_CNT = 213 * MiB + 256 * 1024;
constexpr size_t WS_EST = 213 * MiB + 512 * 1024;
constexpr size_t WS_RSROW = 214 * MiB;
constexpr size_t WS_GATEROW = 215 * MiB;
constexpr size_t WS_U = 216 * MiB;
constexpr size_t WS_Z = 344 * MiB;
constexpr size_t WS_Q = WS_Z;
constexpr size_t WS_KV = WS_Z + 64 * MiB;
constexpr size_t WS_HQ = WS_Z + 96 * MiB;
constexpr size_t WS_HF = WS_Z + 160 * MiB;
constexpr size_t WS_HI = WS_Z + 224 * MiB;
constexpr size_t WS_HG = WS_Z + 288 * MiB;
constexpr size_t WS_GA = WS_Z + 352 * MiB;
constexpr size_t WS_GB = WS_Z + 480 * MiB;
constexpr size_t WS_XS = WS_Z;
constexpr size_t WS_ACT = WS_Z + 272 * MiB;
constexpr size_t WS_END = WS_Z + 608 * MiB;
static_assert((size_t)HALF_ROWS * 2048 == 272 * MiB, "half rows");
static_assert(WS_ACT + 272 * MiB <= WS_END && WS_END <= 1024 * MiB, "ws map");

constexpr int LDS_BYTES = 147456;
constexpr int RING_BYTES = 131072;
constexpr int MISC_OFF = RING_BYTES + 320;

typedef float f32x16 __attribute__((ext_vector_type(16)));
typedef unsigned u32x2 __attribute__((ext_vector_type(2)));

__device__ __forceinline__ float bf2f(unsigned short v) { return __builtin_bit_cast(float, (unsigned)v << 16); }
__device__ __forceinline__ float bflo(unsigned w) { return __builtin_bit_cast(float, w << 16); }
__device__ __forceinline__ float bfhi(unsigned w) { return __builtin_bit_cast(float, w & 0xffff0000u); }
__device__ __forceinline__ float sigmoidf_(float x) { return 1.f / (1.f + __expf(-x)); }
__device__ __forceinline__ float wave_sum(float v) {
#pragma unroll
    for (int o = 1; o < 64; o <<= 1) v += __shfl_xor(v, o);
    return v;
}

struct Args { const float* in[18]; float* out; unsigned char* ws; int ph_lo, ph_hi; };
struct Frame {
    LAS unsigned char* lds;
    int tid, lane, wave, G;
    float* out;
    unsigned char* ws;
};

using pg8::Unit;

struct EpiInProj {
    static constexpr bool PERM = true, AFTER_DRAIN = false;
    unsigned char* ws; const float* bias; const float* rope;
    __device__ __forceinline__ void operator()(const pg8::f32x4 (&acc)[2][2][4][2], const Unit& u, int wr, int wc, int fr, int fq) const {
        const int pn = u.pn;
        bf16* dst; int ld, c0;
        if (pn < 2) { dst = (bf16*)(ws + WS_Q); ld = 512; c0 = 256 * pn; }
        else if (pn == 2) { dst = (bf16*)(ws + WS_KV); ld = 256; c0 = 0; }
        else if (pn < 11) { const int k = (pn - 3) >> 1; dst = (bf16*)(ws + WS_HQ + (size_t)k * 64 * MiB); ld = 512; c0 = 256 * ((pn - 3) & 1); }
        else { const int k = (pn - 11) >> 2; dst = (bf16*)(ws + WS_GA + (size_t)k * 128 * MiB); ld = 1024; c0 = 256 * ((pn - 11) & 3); }
        const int row0 = u.pm * 256 + wr * 64 + fr;
#pragma unroll
        for (int bj = 0; bj < 2; ++bj) {
            const int cl = bj * 128 + wc * 32 + 8 * fq;
            const int sc = pn * 256 + cl;
            const bool rp = (pn < 2) || (pn == 2 && bj == 0);
            const int hb = sc & ~63, grp = (sc & 63) >> 3;
            pg8::f32x4 b0, b1;
            if (rp) { b0 = *(const pg8::f32x4*)(bias + hb + grp * 4); b1 = *(const pg8::f32x4*)(bias + hb + 32 + grp * 4); }
            else { b0 = *(const pg8::f32x4*)(bias + sc); b1 = *(const pg8::f32x4*)(bias + sc + 4); }
            const float qs = (pn < 2) ? QSCALE : 1.f;
#pragma unroll
            for (int ai = 0; ai < 2; ++ai)
#pragma unroll
                for (int m = 0; m < 4; ++m) {
                    const int row = row0 + ai * 128 + m * 16;
                    pg8::f32x4 v0 = acc[ai][bj][m][0] + b0, v1 = acc[ai][bj][m][1] + b1;
                    if (rp) {
                        const int pos = row & (SEQ - 1);
                        const pg8::f32x4 cs = *(const pg8::f32x4*)(rope + pos * 32 + grp * 4);
                        const pg8::f32x4 sn = *(const pg8::f32x4*)(rope + SEQ * 32 + pos * 32 + grp * 4);
                        const pg8::f32x4 o0 = (v0 * cs - v1 * sn) * qs, o1 = (v1 * cs + v0 * sn) * qs;
                        v0 = o0; v1 = o1;
                    }
                    pg8::u32x4 w; w.x = pg8::cvt_pk_bf16(v0[0], v0[1]); w.y = pg8::cvt_pk_bf16(v0[2], v0[3]); w.z = pg8::cvt_pk_bf16(v1[0], v1[1]); w.w = pg8::cvt_pk_bf16(v1[2], v1[3]);
                    *(pg8::u32x4*)(dst + (size_t)row * ld + c0 + cl) = w;
                }
        }
    }
};

template <int MODE> struct EpiGate {
    static constexpr bool PERM = true, AFTER_DRAIN = false;
    bf16* Gb; const bf16* Tb;
    __device__ __forceinline__ void operator()(const pg8::f32x4 (&acc)[2][2][4][2], const Unit& u, int wr, int wc, int fr, int fq) const {
        const int row0 = u.pm * 256 + wr * 64 + fr;
#pragma unroll
        for (int ai = 0; ai < 2; ++ai)
#pragma unroll
            for (int m = 0; m < 4; ++m) {
                const int row = row0 + ai * 128 + m * 16;
#pragma unroll
                for (int bj = 0; bj < 2; ++bj) {
                    const size_t off = (size_t)row * 1024 + u.pn * 256 + bj * 128 + wc * 32 + 8 * fq;
                    const pg8::u32x4 gv = *(const pg8::u32x4*)(Gb + off);
                    pg8::u32x4 tv = {0u, 0u, 0u, 0u};
                    if (MODE == 1) tv = *(const pg8::u32x4*)(Tb + off);
                    float o[8];
#pragma unroll
                    for (int i = 0; i < 4; ++i) {
                        const unsigned gw = gv[i], tw = tv[i];
                        const pg8::f32x4 a = acc[ai][bj][m][i >> 1];
                        const float a0 = a[(i & 1) * 2], a1 = a[(i & 1) * 2 + 1];
                        o[2 * i] = sigmoidf_(bflo(gw)) * a0 + (MODE == 1 ? bflo(tw) : 0.f);
                        o[2 * i + 1] = sigmoidf_(bfhi(gw)) * a1 + (MODE == 1 ? bfhi(tw) : 0.f);
                    }
                    pg8::u32x4 w; w.x = pg8::cvt_pk_bf16(o[0], o[1]); w.y = pg8::cvt_pk_bf16(o[2], o[3]); w.z = pg8::cvt_pk_bf16(o[4], o[5]); w.w = pg8::cvt_pk_bf16(o[6], o[7]);
                    *(pg8::u32x4*)(Gb + off) = w;
                }
            }
    }
};

struct EpiResid {
    static constexpr bool PERM = true, AFTER_DRAIN = false;
    const float* x; float* out; bf16* U2; const float* gffn;
    __device__ __forceinline__ void operator()(const pg8::f32x4 (&acc)[2][2][4][2], const Unit& u, int wr, int wc, int fr, int fq) const {
        const int row0 = u.pm * 256 + wr * 64 + fr;
#pragma unroll
        for (int bj = 0; bj < 2; ++bj) {
            const int col = u.pn * 256 + bj * 128 + wc * 32 + 8 * fq;
            const pg8::f32x4 g0 = *(const pg8::f32x4*)(gffn + col), g1 = *(const pg8::f32x4*)(gffn + col + 4);
#pragma unroll
            for (int ai = 0; ai < 2; ++ai)
#pragma unroll
                for (int m = 0; m < 4; ++m) {
                    const size_t off = (size_t)(row0 + ai * 128 + m * 16) * 1024 + col;
                    const pg8::f32x4 h0 = *(const pg8::f32x4*)(x + off) + acc[ai][bj][m][0], h1 = *(const pg8::f32x4*)(x + off + 4) + acc[ai][bj][m][1];
                    *(pg8::f32x4*)(out + off) = h0; *(pg8::f32x4*)(out + off + 4) = h1;
                    const pg8::f32x4 s0 = h0 * g0, s1 = h1 * g1;
                    pg8::u32x4 w; w.x = pg8::cvt_pk_bf16(s0[0], s0[1]); w.y = pg8::cvt_pk_bf16(s0[2], s0[3]); w.z = pg8::cvt_pk_bf16(s1[0], s1[1]); w.w = pg8::cvt_pk_bf16(s1[2], s1[3]);
                    *(pg8::u32x4*)(U2 + off) = w;
                }
        }
    }
};

struct EpiSwiGlu {
    static constexpr bool PERM = true, AFTER_DRAIN = false;
    bf16* act; const float* b1; const float* rsrow;
    __device__ __forceinline__ void operator()(const pg8::f32x4 (&acc)[2][2][4][2], const Unit& u, int wr, int wc, int fr, int fq) const {
        const int e = u.pn >> 3, ct = u.pn & 7;
        const int j0 = 128 * ct + 32 * wc + 8 * fq;
        const float* bp = b1 + (size_t)e * 2048 + j0;
        const pg8::f32x4 bg0 = *(const pg8::f32x4*)(bp), bg1 = *(const pg8::f32x4*)(bp + 4), bl0 = *(const pg8::f32x4*)(bp + 1024), bl1 = *(const pg8::f32x4*)(bp + 1028);
        const int row0 = u.pm * 256 + wr * 64 + fr;
#pragma unroll
        for (int ai = 0; ai < 2; ++ai)
#pragma unroll
            for (int m = 0; m < 4; ++m) {
                const int row = row0 + ai * 128 + m * 16;
                const float rs = rsrow[row];
                float o[8];
#pragma unroll
                for (int n = 0; n < 2; ++n) {
                    const pg8::f32x4 g = acc[ai][0][m][n] * rs + (n ? bg1 : bg0), l = acc[ai][1][m][n] * rs + (n ? bl1 : bl0);
#pragma unroll
                    for (int i = 0; i < 4; ++i) {
                        const float gg = fminf(g[i], 7.f), ll = fminf(fmaxf(l[i], -7.f), 7.f);
                        o[4 * n + i] = gg * sigmoidf_(1.702f * gg) * (ll + 1.f);
                    }
                }
                pg8::u32x4 w; w.x = pg8::cvt_pk_bf16(o[0], o[1]); w.y = pg8::cvt_pk_bf16(o[2], o[3]); w.z = pg8::cvt_pk_bf16(o[4], o[5]); w.w = pg8::cvt_pk_bf16(o[6], o[7]);
                *(pg8::u32x4*)(act + (size_t)row * 1024 + j0) = w;
            }
    }
};

struct EpiMoeOut {
    static constexpr bool PERM = true, AFTER_DRAIN = false;
    bf16* y; const float* b2; const float* gaterow;
    __device__ __forceinline__ void operator()(const pg8::f32x4 (&acc)[2][2][4][2], const Unit& u, int wr, int wc, int fr, int fq) const {
        const int e = u.pn >> 2, ct = u.pn & 3;
        const int row0 = u.pm * 256 + wr * 64 + fr;
#pragma unroll
        for (int bj = 0; bj < 2; ++bj) {
            const int col = 256 * ct + 128 * bj + 32 * wc + 8 * fq;
            const pg8::f32x4 b0 = *(const pg8::f32x4*)(b2 + (size_t)e * 1024 + col), bb1 = *(const pg8::f32x4*)(b2 + (size_t)e * 1024 + col + 4);
#pragma unroll
            for (int ai = 0; ai < 2; ++ai)
#pragma unroll
                for (int m = 0; m < 4; ++m) {
                    const int row = row0 + ai * 128 + m * 16;
                    const float gt = gaterow[row];
                    const pg8::f32x4 v0 = (acc[ai][bj][m][0] + b0) * gt, v1 = (acc[ai][bj][m][1] + bb1) * gt;
                    pg8::u32x4 w; w.x = pg8::cvt_pk_bf16(v0[0], v0[1]); w.y = pg8::cvt_pk_bf16(v0[2], v0[3]); w.z = pg8::cvt_pk_bf16(v1[0], v1[1]); w.w = pg8::cvt_pk_bf16(v1[2], v1[3]);
                    *(pg8::u32x4*)(y + (size_t)row * 1024 + col) = w;
                }
        }
    }
};

struct MoeOrder {
    unsigned pk[16]; int ntiles, sh, c, G;
    __device__ __forceinline__ void init(const int* est, int lane, int nct_shift, int G_, int c_) {
        const int v = est[lane & 63];
        int st[33];
#pragma unroll
        for (int k = 0; k < 33; ++k) st[k] = __builtin_amdgcn_readlane(v, k);
#pragma unroll
        for (int k = 0; k < 16; ++k) pk[k] = (unsigned)st[2 * k] | ((unsigned)st[2 * k + 1] << 16);
        ntiles = st[32]; sh = nct_shift; G = G_; c = (G_ % 8 == 0) ? (c_ % 8) * (G_ / 8) + c_ / 8 : c_;
    }
    __device__ __forceinline__ bool next(int i, Unit& u) const {
        const int uid = i * G + c, rt = uid >> sh, ct = uid & ((1 << sh) - 1);
        if (rt >= ntiles) return false;
        int e = 0;
#pragma unroll
        for (int k = 1; k < 32; ++k) e += (rt >= (int)((pk[k >> 1] >> (16 * (k & 1))) & 0xffffu)) ? 1 : 0;
        u.pm = rt; u.pn = (e << sh) + ct; return true;
    }
    __device__ __forceinline__ void a_ready(const Unit&) const {}
    __device__ __forceinline__ void done(const Unit&) const {}
};

template <class RowMap>
__device__ __forceinline__ void transpose_item(const float* W, int K, int N, bf16* WT, const RowMap& rm, LAS float* scr, int item, int lane) {
    const int nblk = N / 32, kb = item / nblk, nb = item % nblk, k0 = 64 * kb, n0 = 32 * nb;
#pragma unroll 8
    for (int i = 0; i < 32; ++i) { const int kk = 2 * i + (lane >> 5); scr[kk * 33 + (lane & 31)] = W[(size_t)(k0 + kk) * N + n0 + (lane & 31)]; }
    LDS_WAIT(); asm volatile("" ::: "memory");
    const int c = lane & 7;
#pragma unroll
    for (int j = 0; j < 4; ++j) { const int n = (lane >> 3) + 8 * j; const LAS float* s = scr + (8 * c) * 33 + n;
        v4u o; o.x = pk2(s[0 * 33], s[1 * 33]); o.y = pk2(s[2 * 33], s[3 * 33]); o.z = pk2(s[4 * 33], s[5 * 33]); o.w = pk2(s[6 * 33], s[7 * 33]);
        *(GAS v4u*)(WT + (size_t)rm(n0 + n) * K + k0 + 8 * c) = o; }
    LDS_WAIT(); asm volatile("" ::: "memory");
}
struct RmId { __device__ __forceinline__ int operator()(int n) const { return n; } };
struct RmIn {
    __device__ __forceinline__ int operator()(int n) const {
        if (n >= 640) return n;
        const int hb = n & ~63, d = n & 63, half = d >> 5, grp = (d & 31) >> 2, j = d & 3;
        return hb + grp * 8 + half * 4 + j;
    }
};
struct RmW1 {
    __device__ __forceinline__ int operator()(int n) const { const int lin = n >> 10, j = n & 1023; return (j >> 7) * 256 + lin * 128 + (j & 127); }
};

__device__ __forceinline__ void p0_prologue(Frame& F, const Args& A) {
    LAS float* scr = (LAS float*)(F.lds + F.wave * 16384);
    const int gw = blockIdx.x * NWAVES + F.wave, NGW = F.G * NWAVES;
    unsigned char* ws = F.ws;
    constexpr int I_IN = 16 * (INC / 32), I_UA = 8 * 32, I_OUT = 16 * 32, I_W1 = 16 * 64, I_W2 = 16 * 32;
    constexpr int NITEMS = I_IN + 2 * I_UA + I_OUT + NEXP * (I_W1 + I_W2);
    for (int it = gw; it < NITEMS; it += NGW) {
        int r = it;
        if (r < I_IN) { transpose_item(A.in[2], 1024, INC, (bf16*)(ws + WS_WIN), RmIn(), scr, r, F.lane); continue; } r -= I_IN;
        if (r < I_UA) { transpose_item(A.in[7], 512, 1024, (bf16*)(ws + WS_WUA), RmId(), scr, r, F.lane); continue; } r -= I_UA;
        if (r < I_UA) { transpose_item(A.in[8], 512, 1024, (bf16*)(ws + WS_WUH), RmId(), scr, r, F.lane); continue; } r -= I_UA;
        if (r < I_OUT) { transpose_item(A.in[9], 1024, 1024, (bf16*)(ws + WS_WOUT), RmId(), scr, r, F.lane); continue; } r -= I_OUT;
        if (r < NEXP * I_W1) { const int e = r / I_W1; transpose_item(A.in[13] + (size_t)e * 1024 * 2048, 1024, 2048, (bf16*)(ws + WS_W1) + (size_t)e * 2048 * 1024, RmW1(), scr, r % I_W1, F.lane); continue; } r -= NEXP * I_W1;
        { const int e = r / I_W2; transpose_item(A.in[15] + (size_t)e * 1024 * 1024, 1024, 1024, (bf16*)(ws + WS_W2) + (size_t)e * 1024 * 1024, RmId(), scr, r % I_W2, F.lane); }
    }
    const int gt = blockIdx.x * (NWAVES * 64) + F.tid, NGT = F.G * NWAVES * 64;
    { bf16* wh = (bf16*)(ws + WS_WRT); bf16* wl = wh + 32 * 1024;
      for (int i = gt; i < 32 * 1024; i += NGT) { const int e = i >> 10, k = i & 1023; const float v = A.in[10][k] * A.in[11][k * 32 + e];
          const unsigned h = f2bf(v); const float r = v - bf2f((unsigned short)h); wh[i] = (bf16)h; wl[i] = (bf16)f2bf(r); } }
    { float* rc = (float*)(ws + WS_ROPE); float* rsn = rc + SEQ * 32;
      for (int i = gt; i < SEQ * 32; i += NGT) { const int pos = i >> 5, j = i & 31;
          const float inv = (float)pow(10000.0, -(double)j / 32.0); const float ang = (float)pos * inv;
          rc[i] = (float)cos((double)ang); rsn[i] = (float)sin((double)ang); } }
    { const float* x = A.in[0]; const float* g = A.in[1]; bf16* U = (bf16*)(ws + WS_U);
      f32x4 gv[4];
#pragma unroll
      for (int j = 0; j < 4; ++j) gv[j] = *(const f32x4*)(g + 256 * j + 4 * F.lane);
      for (int m = gw; m < NTOK; m += NGW) {
          const GAS f32x4* xr = (const GAS f32x4*)(x + (size_t)m * DM) + F.lane;
          f32x4 v[4]; float s = 0.f;
#pragma unroll
          for (int j = 0; j < 4; ++j) { v[j] = xr[64 * j]; s += (v[j].x * v[j].x + v[j].y * v[j].y) + (v[j].z * v[j].z + v[j].w * v[j].w); }
          const float rs = rsqrtf(wave_sum(s) * (1.f / DM) + NORM_EPS);
          GAS unsigned long long* o8 = (GAS unsigned long long*)(U + (size_t)m * DM) + F.lane;
#pragma unroll
          for (int j = 0; j < 4; ++j) { const f32x4 t = v[j] * rs * gv[j]; o8[64 * j] = (unsigned long long)pk2(t.x, t.y) | ((unsigned long long)pk2(t.z, t.w) << 32); }
      } }
}

__device__ __forceinline__ void attn_naive(Frame& F, const Args& A, int wg0, int nwg) {
    bf16* Q = (bf16*)(F.ws + WS_Q); const bf16* KV = (const bf16*)(F.ws + WS_KV);
    const float* sinks = A.in[4];
    const int gt = (blockIdx.x - wg0) * (NWAVES * 64) + F.tid, NGT = nwg * NWAVES * 64;
    for (int idx = gt; idx < NTOK * 8; idx += NGT) {
        const int h = idx & 7, tok = idx >> 3, t = tok & (SEQ - 1), kvh = h >> 2;
        float q[64], o[64];
        { const v4u* qp = (const v4u*)(Q + (size_t)tok * 512 + h * 64);
#pragma unroll
          for (int c = 0; c < 8; ++c) { const v4u w = qp[c];
#pragma unroll
              for (int i = 0; i < 4; ++i) { q[8 * c + 2 * i] = bflo(w[i]); q[8 * c + 2 * i + 1] = bfhi(w[i]); } } }
#pragma unroll
        for (int d = 0; d < 64; ++d) o[d] = 0.f;
        float m = sinks[h] * LOG2E, l = 1.f;
        const int j0 = (t >= 127) ? t - 127 : 0;
        for (int j = j0; j <= t; ++j) {
            const size_t krow = (size_t)(tok - t + j) * 256;
            const v4u* kp = (const v4u*)(KV + krow + kvh * 64);
            float s = 0.f;
#pragma unroll
            for (int c = 0; c < 8; ++c) { const v4u w = kp[c];
#pragma unroll
                for (int i = 0; i < 4; ++i) { s += q[8 * c + 2 * i] * bflo(w[i]); s += q[8 * c + 2 * i + 1] * bfhi(w[i]); } }
            const float mn = fmaxf(m, s), al = exp2f(m - mn), p = exp2f(s - mn);
            l = l * al + p; m = mn;
            const v4u* vp = (const v4u*)(KV + krow + 128 + kvh * 64);
#pragma unroll
            for (int c = 0; c < 8; ++c) { const v4u w = vp[c];
#pragma unroll
                for (int i = 0; i < 4; ++i) { o[8 * c + 2 * i] = o[8 * c + 2 * i] * al + p * bflo(w[i]); o[8 * c + 2 * i + 1] = o[8 * c + 2 * i + 1] * al + p * bfhi(w[i]); } }
        }
        const float il = 1.f / l;
        v4u* op = (v4u*)(Q + (size_t)tok * 512 + h * 64);
#pragma unroll
        for (int c = 0; c < 8; ++c) { v4u w;
#pragma unroll
            for (int i = 0; i < 4; ++i) w[i] = pk2(o[8 * c + 2 * i] * il, o[8 * c + 2 * i + 1] * il);
            op[c] = w; }
    }
}

__device__ __forceinline__ void hgrn_naive(Frame& F, const Args& A, int wg0, int nwg) {
    bf16* HQ = (bf16*)(F.ws + WS_HQ); const bf16* HFp = (const bf16*)(F.ws + WS_HF); const bf16* HI = (const bf16*)(F.ws + WS_HI); const bf16* HG = (const bf16*)(F.ws + WS_HG);
    const int gi = F.tid >> 7, n = F.tid & 127;
    LAS float* lf = (LAS float*)(F.lds) + gi * 512;
    LAS float* lq = lf + 128; LAS float* red = lf + 256;
    for (int unit = (blockIdx.x - wg0) * 4 + gi; unit < 128 + 3; unit += nwg * 4) {
        const bool act = unit < 128;
        if ((unit - gi) >= 128) break;
        const int b = act ? unit >> 2 : 0, hh = act ? unit & 3 : 0;
        const int ch = hh * 128 + n;
        const float a0 = A.in[5][ch], a1 = A.in[5][512 + ch];
        const float lb = 1.f / (1.f + __expf(a1 - a0));
        const float gn = A.in[6][ch];
        float S[128];
#pragma unroll
        for (int k = 0; k < 128; ++k) S[k] = 0.f;
        for (int t = 0; t < SEQ; ++t) {
            const size_t off = (size_t)(b * SEQ + t) * 512 + ch;
            const float f = lb + (1.f - lb) * sigmoidf_(bf2f(HFp[off]));
            lf[n] = f; lq[n] = bf2f(HQ[off]);
            const float v = bf2f(HI[off]);
            __syncthreads();
            float o = 0.f;
#pragma unroll
            for (int k = 0; k < 128; ++k) { const float fk = lf[k]; S[k] = fk * S[k] + (1.f - fk) * v; o += lq[k] * S[k]; }
            const float ss = wave_sum(o * o);
            if (F.lane == 0) red[(n >> 6)] = ss;
            __syncthreads();
            const float tot = red[0] + red[1];
            const float y = o * rsqrtf(tot * (1.f / 128.f) + NORM_EPS) * gn;
            const float hg = bf2f(HG[off]);
            if (act) HQ[off] = (bf16)f2bf(y * hg * sigmoidf_(hg));
        }
    }
}

__device__ __forceinline__ int crow(int r, int hi) { return (r & 3) + 8 * (r >> 2) + 4 * hi; }
__device__ __forceinline__ void m0_router(Frame& F, const Args& A) {
    unsigned char* ws = F.ws;
    const float* hbuf = F.out; const bf16* wh = (const bf16*)(ws + WS_WRT); const bf16* wl = wh + 32 * 1024;
    int* TOPE = (int*)(ws + WS_TOPE); float* GATE = (float*)(ws + WS_GATE); int* LRANK = (int*)(ws + WS_LRANK); float* RS = (float*)(ws + WS_RS); int* CNT = (int*)(ws + WS_CNT);
    LAS int* hist = (LAS int*)(F.lds + 65536);
    LAS float* scr = (LAS float*)(F.lds) + F.wave * (32 * 33);
    const int r32 = F.lane & 31, hi = F.lane >> 5;
    for (int seg = blockIdx.x; seg < NTOK / 256; seg += F.G) {
        if (F.tid < 32) hist[F.tid] = 0;
        __syncthreads();
        const int tok0 = seg * 256 + F.wave * 32;
        f32x16 acc;
#pragma unroll
        for (int r = 0; r < 16; ++r) acc[r] = 0.f;
        float ssq = 0.f;
        const float* hrow = hbuf + (size_t)(tok0 + r32) * DM + hi * 8;
        const bf16* bhp = wh + r32 * 1024 + hi * 8; const bf16* blp = wl + r32 * 1024 + hi * 8;
#pragma unroll 4
        for (int ks = 0; ks < 64; ++ks) {
            const f32x4 x0 = *(const f32x4*)(hrow + ks * 16), x1 = *(const f32x4*)(hrow + ks * 16 + 4);
            ssq += (x0.x * x0.x + x0.y * x0.y) + (x0.z * x0.z + x0.w * x0.w) + (x1.x * x1.x + x1.y * x1.y) + (x1.z * x1.z + x1.w * x1.w);
            float xs[8] = {x0.x, x0.y, x0.z, x0.w, x1.x, x1.y, x1.z, x1.w};
            bf16x8 ah, al;
#pragma unroll
            for (int j = 0; j < 8; ++j) { const unsigned h = f2bf(xs[j]); ah[j] = (short)h; al[j] = (short)f2bf(xs[j] - bf2f((unsigned short)h)); }
            const bf16x8 bh = *(const bf16x8*)(bhp + ks * 16), bl = *(const bf16x8*)(blp + ks * 16);
            acc = __builtin_amdgcn_mfma_f32_32x32x16_bf16(ah, bh, acc, 0, 0, 0);
            acc = __builtin_amdgcn_mfma_f32_32x32x16_bf16(al, bh, acc, 0, 0, 0);
            acc = __builtin_amdgcn_mfma_f32_32x32x16_bf16(ah, bl, acc, 0, 0, 0);
        }
        ssq += __shfl_xor(ssq, 32);
#pragma unroll
        for (int r = 0; r < 16; ++r) scr[crow(r, hi) * 33 + r32] = acc[r];
        __builtin_amdgcn_s_waitcnt(0xC07F);
        if (F.lane < 32) {
            const int tok = tok0 + F.lane;
            const float rs = rsqrtf(ssq * (1.f / DM) + NORM_EPS);
            float v0 = -INFINITY, v1 = -INFINITY, v2 = -INFINITY, v3 = -INFINITY; int i0 = 0, i1 = 0, i2 = 0, i3 = 0;
#pragma unroll
            for (int e = 0; e < 32; ++e) {
                const float x = scr[F.lane * 33 + e] * rs + A.in[12][e];
                if (x > v3) {
                    if (x > v2) { v3 = v2; i3 = i2;
                        if (x > v1) { v2 = v1; i2 = i1;
                            if (x > v0) { v1 = v0; i1 = i0; v0 = x; i0 = e; } else { v1 = x; i1 = e; } }
                        else { v2 = x; i2 = e; } }
                    else { v3 = x; i3 = e; } }
            }
            const float e1 = __expf(v1 - v0), e2 = __expf(v2 - v0), e3 = __expf(v3 - v0), inv = 1.f / (1.f + e1 + e2 + e3);
            const int l0 = atomicAdd((int*)&hist[i0], 1), l1 = atomicAdd((int*)&hist[i1], 1), l2 = atomicAdd((int*)&hist[i2], 1), l3 = atomicAdd((int*)&hist[i3], 1);
            *(int4*)(TOPE + tok * 4) = make_int4(i0, i1, i2, i3);
            *(float4*)(GATE + tok * 4) = make_float4(inv, e1 * inv, e2 * inv, e3 * inv);
            *(int4*)(LRANK + tok * 4) = make_int4(l0, l1, l2, l3);
            RS[tok] = rs;
        }
        __syncthreads();
        if (F.tid < 32) CNT[seg * 32 + F.tid] = hist[F.tid];
        __syncthreads();
    }
}

__device__ __forceinline__ void m1_dispatch(Frame& F, int p) {
    unsigned char* ws = F.ws;
    const int* TOPE = (const int*)(ws + WS_TOPE); const float* GATE = (const float*)(ws + WS_GATE); const int* LRANK = (const int*)(ws + WS_LRANK); const float* RS = (const float*)(ws + WS_RS);
    const int* CNT = (const int*)(ws + WS_CNT); int* EST = (int*)(ws + WS_EST); int* ROWOF = (int*)(ws + WS_ROWOF);
    float* RSROW = (float*)(ws + WS_RSROW); float* GATEROW = (float*)(ws + WS_GATEROW);
    const bf16* U2 = (const bf16*)(ws + WS_U); bf16* XS = (bf16*)(ws + WS_XS);
    LAS int* cum = (LAS int*)(F.lds); LAS int* part = cum + 4096; LAS int* tot = part + 512; LAS int* tst = tot + 32;
    __syncthreads();
    for (int i = F.tid; i < 4096; i += NWAVES * 64) cum[i] = CNT[p * 4096 + i];
    __syncthreads();
    { const int e = F.tid & 31, pt = F.tid >> 5; int s = 0;
      for (int j = 0; j < 8; ++j) { const int idx = (8 * pt + j) * 32 + e; const int t = cum[idx]; cum[idx] = s; s += t; }
      part[pt * 32 + e] = s; }
    __syncthreads();
    { const int e = F.tid & 31, pt = F.tid >> 5; int off = 0;
      for (int q = 0; q < pt; ++q) off += part[q * 32 + e];
      for (int j = 0; j < 8; ++j) cum[(8 * pt + j) * 32 + e] += off;
      if (pt == 15) tot[e] = off + part[15 * 32 + e]; }
    __syncthreads();
    if (F.tid == 0) { int a = 0; for (int e = 0; e < 32; ++e) { tst[e] = a; a += (tot[e] + 255) >> 8; } tst[32] = a; }
    __syncthreads();
    if (blockIdx.x == 0 && F.tid < 64) EST[p * 64 + F.tid] = (F.tid <= 32) ? tst[F.tid] : 0;
    for (int e = blockIdx.x; e < 32; e += F.G) {
        const int r0 = 256 * tst[e] + tot[e], r1 = 256 * tst[e + 1];
        for (int r = r0 + F.tid; r < r1; r += NWAVES * 64) { RSROW[r] = 0.f; GATEROW[r] = 0.f; }
    }
    const int gw = blockIdx.x * NWAVES + F.wave, NGW = F.G * NWAVES;
    for (int tok = p * HALF_TOK + gw; tok < (p + 1) * HALF_TOK; tok += NGW) {
        int row = 0;
        if (F.lane < 4) {
            const int e = TOPE[tok * 4 + F.lane];
            row = 256 * tst[e] + cum[((tok >> 8) - 128 * p) * 32 + e] + LRANK[tok * 4 + F.lane];
            ROWOF[tok * 4 + F.lane] = row; RSROW[row] = RS[tok]; GATEROW[row] = GATE[tok * 4 + F.lane];
        }
        const v4u a = *(const v4u*)(U2 + (size_t)tok * 1024 + F.lane * 8), b = *(const v4u*)(U2 + (size_t)tok * 1024 + 512 + F.lane * 8);
#pragma unroll
        for (int k = 0; k < 4; ++k) { const int rk = __builtin_amdgcn_readlane(row, k);
            *(v4u*)(XS + (size_t)rk * 1024 + F.lane * 8) = a; *(v4u*)(XS + (size_t)rk * 1024 + 512 + F.lane * 8) = b; }
    }
}

__device__ __forceinline__ void m4_combine(Frame& F, const Args& A, int p) {
    unsigned char* ws = F.ws;
    const int* ROWOF = (const int*)(ws + WS_ROWOF); const bf16* Y = (const bf16*)(ws + WS_XS); const float* gf = A.in[17];
    const int gw = blockIdx.x * NWAVES + F.wave, NGW = F.G * NWAVES;
    f32x4 gv[4];
#pragma unroll
    for (int j = 0; j < 4; ++j) gv[j] = *(const f32x4*)(gf + 256 * j + 4 * F.lane);
    for (int tok = p * HALF_TOK + gw; tok < (p + 1) * HALF_TOK; tok += NGW) {
        const int rv = ROWOF[tok * 4 + (F.lane & 3)];
        int rk[4];
#pragma unroll
        for (int k = 0; k < 4; ++k) rk[k] = __builtin_amdgcn_readlane(rv, k);
        float* hp = F.out + (size_t)tok * DM + 4 * F.lane;
        f32x4 v[4]; float s = 0.f;
#pragma unroll
        for (int j = 0; j < 4; ++j) {
            v[j] = *(const f32x4*)(hp + 256 * j);
#pragma unroll
            for (int k = 0; k < 4; ++k) { const u32x2 w = *(const u32x2*)(Y + (size_t)rk[k] * 1024 + 256 * j + 4 * F.lane);
                v[j].x += bflo(w.x); v[j].y += bfhi(w.x); v[j].z += bflo(w.y); v[j].w += bfhi(w.y); }
            s += (v[j].x * v[j].x + v[j].y * v[j].y) + (v[j].z * v[j].z + v[j].w * v[j].w);
        }
        const float rs = rsqrtf(wave_sum(s) * (1.f / DM) + NORM_EPS);
#pragma unroll
        for (int j = 0; j < 4; ++j) *(f32x4*)(hp + 256 * j) = v[j] * rs * gv[j];
    }
}

constexpr int NPH = 15;
template <unsigned MASK> __global__ void __launch_bounds__(NWAVES * 64, 2) mega_fwd(Args args) {
    extern __shared__ __attribute__((aligned(16))) unsigned char lds[];
    Frame F;
    F.lds = (LAS unsigned char*)lds;
    F.tid = threadIdx.x; F.lane = F.tid & 63; F.wave = __builtin_amdgcn_readfirstlane(F.tid >> 6); F.G = gridDim.x;
    F.out = args.out; F.ws = args.ws;
    unsigned char* ws = args.ws;
    volatile LAS unsigned* MISC = (volatile LAS unsigned*)(F.lds + MISC_OFF);
    for (int u = F.tid; u < (LDS_BYTES - RING_BYTES) / 4; u += NWAVES * 64) ((LAS unsigned*)(F.lds + RING_BYTES))[u] = 0u;
    __syncthreads();
    const int lo = args.ph_lo, hi = args.ph_hi;
    XcdBarrier bar; bar.bar = (unsigned*)(ws + WS_CTL) + CW_BAR; bar.x = 0; bar.st = nullptr;
    if (hi - lo > 1) bar = xcd_barrier_post((unsigned*)(ws + WS_CTL) + CW_BAR, MISC + 8);
#define HAS(k) ((MASK >> (k)) & 1u)
#define IN(k) (lo <= (k) && (k) < hi)
#define SEAM(k) do { if (IN(k) && IN((k) + 1)) xcd_barrier(bar); } while (0)

    if (HAS(0) && IN(0)) { p0_prologue(F, args); } SEAM(0);

    if (HAS(1) && IN(1)) {
        pg8::Gemm g{(const pg8::bf16_t*)(ws + WS_U), (const pg8::bf16_t*)(ws + WS_WIN), NTOK, INC, 1024};
        pg8::StaticOrder S; S.init(NTOK, INC, F.G, (int)blockIdx.x);
        EpiInProj E{ws, args.in[3], (const float*)(ws + WS_ROPE)};
        pg8::gemm_phase<EpiInProj, pg8::StaticOrder, true, true>(F.lds, g, S, E);
    } SEAM(1);

    if (HAS(2) && IN(2)) {
        const int half = F.G / 2;
        if ((int)blockIdx.x < half) hgrn_naive(F, args, 0, half); else attn_naive(F, args, half, F.G - half);
    } SEAM(2);

    if (HAS(3) && IN(3)) {
        pg8::Gemm g{(const pg8::bf16_t*)(ws + WS_Q), (const pg8::bf16_t*)(ws + WS_WUA), NTOK, 1024, 512};
        pg8::StaticOrder S; S.init(NTOK, 1024, F.G, (int)blockIdx.x);
        EpiGate<0> E{(bf16*)(ws + WS_GA), nullptr};
        pg8::gemm_phase<EpiGate<0>, pg8::StaticOrder, true, true>(F.lds, g, S, E);
    } SEAM(3);

    if (HAS(4) && IN(4)) {
        pg8::Gemm g{(const pg8::bf16_t*)(ws + WS_HQ), (const pg8::bf16_t*)(ws + WS_WUH), NTOK, 1024, 512};
        pg8::StaticOrder S; S.init(NTOK, 1024, F.G, (int)blockIdx.x);
        EpiGate<1> E{(bf16*)(ws + WS_GB), (const bf16*)(ws + WS_GA)};
        pg8::gemm_phase<EpiGate<1>, pg8::StaticOrder, true, true>(F.lds, g, S, E);
    } SEAM(4);

    if (HAS(5) && IN(5)) {
        pg8::Gemm g{(const pg8::bf16_t*)(ws + WS_GB), (const pg8::bf16_t*)(ws + WS_WOUT), NTOK, 1024, 1024};
        pg8::StaticOrder S; S.init(NTOK, 1024, F.G, (int)blockIdx.x);
        EpiResid E{args.in[0], F.out, (bf16*)(ws + WS_U), args.in[10]};
        pg8::gemm_phase<EpiResid, pg8::StaticOrder, true, true>(F.lds, g, S, E);
    } SEAM(5);

    if (HAS(6) && IN(6)) { m0_router(F, args); } SEAM(6);

    for (int p = 0; p < 2; ++p) {
        const int k0 = 7 + 4 * p;
        if ((HAS(7) || HAS(11)) && IN(k0)) { m1_dispatch(F, p); } SEAM(k0);
        if ((HAS(8) || HAS(12)) && IN(k0 + 1)) {
            pg8::Gemm g{(const pg8::bf16_t*)(ws + WS_XS), (const pg8::bf16_t*)(ws + WS_W1), HALF_ROWS, 2048, 1024};
            MoeOrder S; S.init((const int*)(ws + WS_EST) + p * 64, F.lane, 3, F.G, (int)blockIdx.x);
            EpiSwiGlu E{(bf16*)(ws + WS_ACT), args.in[14], (const float*)(ws + WS_RSROW)};
            pg8::gemm_phase<EpiSwiGlu, MoeOrder, true, true>(F.lds, g, S, E);
        } SEAM(k0 + 1);
        if ((HAS(9) || HAS(13)) && IN(k0 + 2)) {
            pg8::Gemm g{(const pg8::bf16_t*)(ws + WS_ACT), (const pg8::bf16_t*)(ws + WS_W2), HALF_ROWS, 1024, 1024};
            MoeOrder S; S.init((const int*)(ws + WS_EST) + p * 64, F.lane, 2, F.G, (int)blockIdx.x);
            EpiMoeOut E{(bf16*)(ws + WS_XS), args.in[16], (const float*)(ws + WS_GATEROW)};
            pg8::gemm_phase<EpiMoeOut, MoeOrder, true, true>(F.lds, g, S, E);
        } SEAM(k0 + 2);
        if ((HAS(10) || HAS(14)) && IN(k0 + 3)) { m4_combine(F, args, p); }
        if (p == 0) SEAM(k0 + 3);
    }
#undef IN
#undef SEAM
}

#ifndef MK_SPLIT
#define MK_SPLIT 1
#endif
constexpr unsigned MASK_ALL = (1u << NPH) - 1u;
typedef void (*kern_t)(Args);
template <int K> struct PhaseTab { static void fill(kern_t* t) { t[K] = mega_fwd<(1u << K)>; PhaseTab<K - 1>::fill(t); } };
template <> struct PhaseTab<-1> { static void fill(kern_t*) {} };
extern "C" void kernel_launch(void* const* d_in, const int* in_sizes, int n_in, void* d_out, int out_size, void* d_ws, size_t ws_size, hipStream_t stream) {
    static int grid = 0;
    static kern_t tab[NPH + 1];
    if (grid == 0) {
        if (n_in != 18 || out_size != NTOK * DM || ws_size < WS_END) { fprintf(stderr, "kernel_launch: unexpected shapes (n_in %d out %d ws %zu)\n", n_in, out_size, ws_size); grid = -1; return; }
        int dev = 0, cus = 0, per_cu = 0;
        if (hipGetDevice(&dev) != hipSuccess || hipDeviceGetAttribute(&cus, hipDeviceAttributeMultiprocessorCount, dev) != hipSuccess) { grid = -1; return; }
#if MK_SPLIT
        PhaseTab<NPH - 1>::fill(tab);
        for (int k = 0; k < NPH; ++k)
            if (hipFuncSetAttribute((const void*)tab[k], hipFuncAttributeMaxDynamicSharedMemorySize, LDS_BYTES) != hipSuccess) { fprintf(stderr, "kernel_launch: hipFuncSetAttribute failed\n"); grid = -1; return; }
#else
        tab[NPH] = mega_fwd<MASK_ALL>;
        if (hipFuncSetAttribute((const void*)tab[NPH], hipFuncAttributeMaxDynamicSharedMemorySize, LDS_BYTES) != hipSuccess) { fprintf(stderr, "kernel_launch: hipFuncSetAttribute failed\n"); grid = -1; return; }
        if (hipOccupancyMaxActiveBlocksPerMultiprocessor(&per_cu, (const void*)tab[NPH], NWAVES * 64, LDS_BYTES) != hipSuccess || per_cu < 1) { fprintf(stderr, "kernel_launch: occupancy query says %d\n", per_cu); }
#endif
        (void)hipGetLastError();
        grid = cus;
        if (grid > 256) grid = 256;
    }
    if (grid < 0) return;
    (void)hipMemsetAsync((char*)d_ws + WS_CTL, 0, CTL_ZERO_BYTES, stream);
    Args a{};
    for (int i = 0; i < 18; ++i) a.in[i] = (const float*)d_in[i];
    a.out = (float*)d_out; a.ws = (unsigned char*)d_ws;
#if MK_SPLIT
    for (int k = 0; k < NPH; ++k) { a.ph_lo = k; a.ph_hi = k + 1; hipLaunchKernelGGL(tab[k], dim3(grid), dim3(NWAVES * 64), LDS_BYTES, stream, a); }
#else
    a.ph_lo = 0; a.ph_hi = NPH; hipLaunchKernelGGL(tab[NPH], dim3(grid), dim3(NWAVES * 64), LDS_BYTES, stream, a);
#endif
}
```

```cpp
#include <hip/hip_runtime.h>
#include <cstdio>
#include <cstdint>
namespace pg8 {
#define PG8_LAS __attribute__((address_space(3)))
typedef unsigned short bf16_t;
typedef short bf16x8 __attribute__((ext_vector_type(8)));
typedef float f32x4 __attribute__((ext_vector_type(4)));
typedef unsigned u32x4 __attribute__((ext_vector_type(4)));
typedef int v4i_ __attribute__((ext_vector_type(4)));
typedef int v8i_ __attribute__((ext_vector_type(8)));
constexpr int BM = 256, BK = 64, HALF = 128, HTB = HALF * BK * 2  , STAGE_BYTES = 8 * HTB, NXCD = 8, WGM = 8;

__host__ __device__ __forceinline__ int lds_byte(int r, int c) { const int st = (r >> 4) * 2 + (c >> 5), rr = r & 15, cc = c & 31, ob = rr * 64 + cc * 2; return st * 1024 + (ob ^ (((ob >> 9) & 1) << 5)); }
__host__ __device__ __forceinline__ void stage_rc(int b, int& R, int& C) { const int st = b / 1024, sb = b % 1024, swz = sb ^ (((sb >> 9) & 1) << 5); R = (st >> 1) * 16 + swz / 64; C = (st & 1) * 32 + (swz % 64) / 2; }
__host__ __device__ __forceinline__ int perm32(int rho) { const int n = rho >> 4, i = rho & 15; return 8 * (i >> 2) + 4 * n + (i & 3); }

struct Unit { int pm, pn; };
struct Gemm { const bf16_t* A; const bf16_t* Bt; int M, N, K; const bf16_t* A2; const bf16_t* Bt2; int sw, sx; };

struct StaticOrder {
    int nM, nN, nwg, G, c;
    __host__ __device__ void init(int M, int N, int G_, int c_) { nM = M / BM; nN = N / BM; nwg = nM * nN; G = G_; c = c_; }
    __host__ __device__ bool next(int i, Unit& u) const {
        const long L = (long)i * G + c; if (L >= nwg) return false;
        int wgid = (int)L; { const int q = nwg / NXCD, r = nwg % NXCD, xcd = wgid % NXCD, off = wgid / NXCD; wgid = (xcd < r ? xcd * (q + 1) : r * (q + 1) + (xcd - r) * q) + off; }
        const int nig = WGM * nN, gid = wgid / nig, fm = gid * WGM, gsz = (nM - fm) < WGM ? (nM - fm) : WGM;
        u.pm = fm + ((wgid % nig) % gsz); u.pn = (wgid % nig) / gsz; return true;
    }
    __device__ __forceinline__ int krot(const Unit& u, int nt) const { return (2 * (u.pn + (u.pm >> 1))) & (nt - 1); }
    __device__ __forceinline__ void a_ready(const Unit&) const {}
    __device__ __forceinline__ void done(const Unit&) const {}
};
__device__ __forceinline__ unsigned cvt_pk_bf16(float lo, float hi) { unsigned r; asm volatile("v_cvt_pk_bf16_f32 %0, %1, %2" : "=v"(r) : "v"(lo), "v"(hi)); return r; }
template <class Epi, class Sched, bool ALIGN_EPI = false, bool SP2 = false, bool FP8 = false, bool PAIR = false>
__device__ __forceinline__ void gemm_phase(PG8_LAS unsigned char* lds, const Gemm g, const Sched& S, const Epi& E) {
    const int tid = threadIdx.x, wid = __builtin_amdgcn_readfirstlane(tid >> 6), lane = tid & 63, wr = wid >> 2, wc = wid & 3, fr = lane & 15, fq = lane >> 4;
    const int K = g.K, nt = K / BK;
    unsigned voffA[2], voffB[2];
#pragma unroll
    for (int i = 0; i < 2; ++i) { int R, C; stage_rc(tid * 16 + i * 8192, R, C); const int Rb = Epi::PERM ? ((R & ~31) + perm32(R & 31)) : R;
        voffA[i] = (unsigned)(R * K + C) * 2u; voffB[i] = (unsigned)(Rb * K + C) * 2u; }
    const size_t kstep = (size_t)(BK * 2);
    const size_t hstep = (size_t)HALF * K * 2;
    const size_t tstep = 2 * hstep;
    const unsigned ldsw = (unsigned)wid * 1024u;
    const int aoff = lds_byte(wr * 64 + fr, fq * 8), boff = lds_byte(wc * 32 + fr, fq * 8);
#define PG8_SA(b, h) (((b) * 2 + (h)) * HTB)
#define PG8_SB(b, h) ((4 + (b) * 2 + (h)) * HTB)
#define PG8_STAGE(bufoff, gbase, voff) do { _Pragma("unroll") for (int _i = 0; _i < 2; ++_i) \
        __builtin_amdgcn_global_load_lds((const unsigned*)((const char*)(gbase) + (voff)[_i]), (PG8_LAS unsigned*)(lds + (bufoff) + ldsw + _i * 8192), 16, 0, 0); } while (0)
#define PG8_LDA(dst, b, h) do { if constexpr (FP8) { _Pragma("unroll") for (int m = 0; m < 4; ++m) { const v4i_ lo_ = *(const PG8_LAS v4i_*)(lds + PG8_SA(b, h) + aoff + m * 2048), hi_ = *(const PG8_LAS v4i_*)(lds + PG8_SA(b, h) + aoff + m * 2048 + 1024); dst##8[m] = __builtin_shufflevector(lo_, hi_, 0, 1, 2, 3, 4, 5, 6, 7); } } \
        else { _Pragma("unroll") for (int m = 0; m < 4; ++m) _Pragma("unroll") for (int k = 0; k < 2; ++k) dst[m][k] = *(const PG8_LAS bf16x8*)(lds + PG8_SA(b, h) + aoff + m * 2048 + k * 1024); } } while (0)
#define PG8_LDB(dst, b, h) do { if constexpr (FP8) { _Pragma("unroll") for (int n = 0; n < 2; ++n) { const v4i_ lo_ = *(const PG8_LAS v4i_*)(lds + PG8_SB(b, h) + boff + n * 2048), hi_ = *(const PG8_LAS v4i_*)(lds + PG8_SB(b, h) + boff + n * 2048 + 1024); dst##8[n] = __builtin_shufflevector(lo_, hi_, 0, 1, 2, 3, 4, 5, 6, 7); } } \
        else { _Pragma("unroll") for (int n = 0; n < 2; ++n) _Pragma("unroll") for (int k = 0; k < 2; ++k) dst[n][k] = *(const PG8_LAS bf16x8*)(lds + PG8_SB(b, h) + boff + n * 2048 + k * 1024); } } while (0)
#define PG8_MMA(ai, bj, At, Bt) do { \
        if constexpr (FP8) {   \
            _Pragma("unroll") for (int m = 0; m < 4; ++m) asm volatile("" : "+v"(At##8[m])); _Pragma("unroll") for (int n = 0; n < 2; ++n) asm volatile("" : "+v"(Bt##8[n])); } \
        __builtin_amdgcn_s_setprio(1); _Pragma("unroll") for (int m = 0; m < 4; ++m) _Pragma("unroll") for (int n = 0; n < 2; ++n) { \
        if constexpr (FP8) {   \
            acc[ai][bj][m][n] = __builtin_amdgcn_mfma_scale_f32_16x16x128_f8f6f4(Bt##8[n], At##8[m], acc[ai][bj][m][n], 0, 0, 0, g.sw, 0, g.sx); \
        } else { _Pragma("unroll") for (int k = 0; k < 2; ++k) acc[ai][bj][m][n] = __builtin_amdgcn_mfma_f32_16x16x32_bf16(Bt[n][k], At[m][k], acc[ai][bj][m][n], 0, 0, 0); } } \
        if constexpr (FP8) { _Pragma("unroll") for (int m = 0; m < 4; ++m) _Pragma("unroll") for (int n = 0; n < 2; ++n) asm volatile("" : "+v"(acc[ai][bj][m][n])); } \
        __builtin_amdgcn_s_setprio(0); } while (0)
#define PG8_WAIT_V(n) asm volatile("s_waitcnt vmcnt(" #n ")" ::: "memory")
#define PG8_WAIT_L(n) asm volatile("s_waitcnt lgkmcnt(" #n ")" ::: "memory")
#define PG8_BAR __builtin_amdgcn_s_barrier()
#define PG8_SCHED __builtin_amdgcn_sched_barrier(0)
    Unit cur, nxt; int ui = 0;
    if (!S.next(0, cur)) return;
    f32x4 acc[2][2][4][2];
#pragma unroll
    for (int a = 0; a < 2; ++a)
#pragma unroll
        for (int b = 0; b < 2; ++b)
#pragma unroll
            for (int m = 0; m < 4; ++m)
#pragma unroll
                for (int n = 0; n < 2; ++n) acc[a][b][m][n] = (f32x4){0.f, 0.f, 0.f, 0.f};
    bf16x8 At[4][2], B0[2][2], B1[2][2]; v8i_ At8[4], B08[2], B18[2];
    const char* cA = (const char*)g.A + (size_t)cur.pm * tstep; const char* cB = (const char*)g.Bt + (size_t)cur.pn * tstep;
    int krC = S.krot(cur, nt);
    const char* pA = cA + (size_t)krC * kstep; const char* pB = cB + (size_t)krC * kstep;
    S.a_ready(cur);
    if constexpr (SP2) {
        PG8_STAGE(PG8_SB(0, 0), pB, voffB); PG8_STAGE(PG8_SB(0, 1), pB + hstep, voffB); PG8_STAGE(PG8_SA(0, 0), pA, voffA); PG8_STAGE(PG8_SA(0, 1), pA + hstep, voffA);
        if (wr == 1) PG8_BAR;
        PG8_WAIT_V(2); PG8_BAR;
        PG8_STAGE(PG8_SB(1, 0), pB + kstep, voffB); PG8_STAGE(PG8_SA(1, 0), pA + kstep, voffA); PG8_STAGE(PG8_SB(1, 1), pB + hstep + kstep, voffB);
        PG8_WAIT_V(6); PG8_BAR;
    } else {
        PG8_STAGE(PG8_SB(0, 0), pB, voffB); PG8_STAGE(PG8_SA(0, 0), pA, voffA); PG8_STAGE(PG8_SB(0, 1), pB + hstep, voffB); PG8_STAGE(PG8_SA(0, 1), pA + hstep, voffA);
        if (wr == 1) PG8_BAR;
        PG8_WAIT_V(4); PG8_BAR;
        PG8_STAGE(PG8_SB(1, 0), pB + kstep, voffB); PG8_STAGE(PG8_SA(1, 0), pA + kstep, voffA); PG8_STAGE(PG8_SB(1, 1), pB + hstep + kstep, voffB);
        PG8_WAIT_V(6); PG8_BAR;
    }
    for (;;) {
        bool has_next;
        if constexpr (PAIR) { if ((ui & 1) == 0) { nxt = cur; has_next = true; } else has_next = S.next((ui + 1) >> 1, nxt); } else has_next = S.next(ui + 1, nxt);
        const char* nAb = (const char*)g.A; const char* nBb = (const char*)g.Bt;
        if constexpr (PAIR) { if ((ui & 1) == 0) { nAb = (const char*)g.A2; nBb = (const char*)g.Bt2; } }
        const char* nA = has_next ? nAb + (size_t)nxt.pm * tstep : cA; const char* nB = has_next ? nBb + (size_t)nxt.pn * tstep : cB;
        const int krN = has_next ? S.krot(nxt, nt) : krC;
        for (int t = 0; t < nt; t += 2) {
            const bool last = (t == nt - 2);
            const char* a1 = cA + (size_t)((t + 1 + krC) & (nt - 1)) * kstep;
            const size_t k2_ = last ? (size_t)krN * kstep : (size_t)((t + 2 + krC) & (nt - 1)) * kstep;
            const char* a2 = (last ? nA : cA) + k2_; const char* b2 = (last ? nB : cB) + k2_;
            const char* a3 = a2 + kstep; const char* b3 = b2 + kstep;
            if (last && has_next) S.a_ready(nxt);
            if constexpr (SP2) {
            PG8_LDB(B0, 0, 0); PG8_LDB(B1, 0, 1); PG8_SCHED; PG8_LDA(At, 0, 0); PG8_STAGE(PG8_SA(1, 1), a1 + hstep, voffA);
            PG8_WAIT_V(8); PG8_WAIT_L(0); PG8_BAR; PG8_MMA(0, 0, At, B0); PG8_MMA(0, 1, At, B1); PG8_BAR; PG8_SCHED;
            PG8_LDA(At, 0, 1); PG8_STAGE(PG8_SB(0, 0), b2, voffB); PG8_STAGE(PG8_SB(0, 1), b2 + hstep, voffB); PG8_STAGE(PG8_SA(0, 0), a2, voffA);
            PG8_WAIT_V(8); PG8_WAIT_L(0); PG8_BAR; PG8_MMA(1, 0, At, B0); PG8_MMA(1, 1, At, B1); PG8_BAR; PG8_SCHED;
            PG8_LDB(B0, 1, 0); PG8_LDB(B1, 1, 1); PG8_SCHED; PG8_LDA(At, 1, 0); PG8_STAGE(PG8_SA(0, 1), a2 + hstep, voffA);
            PG8_WAIT_V(8); PG8_WAIT_L(0); PG8_BAR; PG8_MMA(0, 0, At, B0); PG8_MMA(0, 1, At, B1); PG8_BAR; PG8_SCHED;
            PG8_LDA(At, 1, 1); PG8_STAGE(PG8_SB(1, 0), b3, voffB); PG8_STAGE(PG8_SB(1, 1), b3 + hstep, voffB); PG8_STAGE(PG8_SA(1, 0), a3, voffA);
            PG8_WAIT_V(8); PG8_WAIT_L(0); PG8_BAR; PG8_MMA(1, 0, At, B0); PG8_MMA(1, 1, At, B1); PG8_BAR; PG8_SCHED;
            } else {
            PG8_LDB(B0, 0, 0); PG8_SCHED; PG8_LDA(At, 0, 0); PG8_STAGE(PG8_SA(1, 1), a1 + hstep, voffA);
            PG8_WAIT_L(8); PG8_BAR; PG8_WAIT_L(0); PG8_MMA(0, 0, At, B0); PG8_BAR; PG8_SCHED;
            PG8_LDB(B1, 0, 1); PG8_STAGE(PG8_SB(0, 0), b2, voffB);
            PG8_BAR; PG8_WAIT_L(0); PG8_MMA(0, 1, At, B1); PG8_BAR;
            PG8_LDA(At, 0, 1); PG8_STAGE(PG8_SA(0, 0), a2, voffA);
            PG8_BAR; PG8_WAIT_L(0); PG8_MMA(1, 0, At, B0); PG8_BAR; PG8_SCHED;
            PG8_STAGE(PG8_SB(0, 1), b2 + hstep, voffB);
            PG8_WAIT_V(6); PG8_BAR; PG8_MMA(1, 1, At, B1); PG8_BAR;
            PG8_LDB(B0, 1, 0); PG8_SCHED; PG8_LDA(At, 1, 0); PG8_STAGE(PG8_SA(0, 1), a2 + hstep, voffA);
            PG8_WAIT_L(8); PG8_BAR; PG8_WAIT_L(0); PG8_MMA(0, 0, At, B0); PG8_BAR; PG8_SCHED;
            PG8_LDB(B1, 1, 1); PG8_STAGE(PG8_SB(1, 0), b3, voffB);
            PG8_BAR; PG8_WAIT_L(0); PG8_MMA(0, 1, At, B1); PG8_BAR;
            PG8_LDA(At, 1, 1); PG8_STAGE(PG8_SA(1, 0), a3, voffA);
            PG8_BAR; PG8_WAIT_L(0); PG8_MMA(1, 0, At, B0); PG8_BAR; PG8_SCHED;
            PG8_STAGE(PG8_SB(1, 1), b3 + hstep, voffB);
            PG8_WAIT_V(6); PG8_BAR; PG8_MMA(1, 1, At, B1); PG8_BAR;
            }
        }
        if constexpr (ALIGN_EPI) { if (wr == 0) PG8_BAR; }
        if constexpr (PAIR) { if ((ui & 1) == 0) E.mid(acc, cur, wr, wc, fr, fq); else E(acc, cur, wr, wc, fr, fq); }
        else if constexpr (!Epi::AFTER_DRAIN) { E(acc, cur, wr, wc, fr, fq); S.done(cur); }
        if (!has_next) break;
        if (!PAIR || (ui & 1)) {
#pragma unroll
        for (int a = 0; a < 2; ++a)
#pragma unroll
            for (int b = 0; b < 2; ++b)
#pragma unroll
                for (int m = 0; m < 4; ++m)
#pragma unroll
                    for (int n = 0; n < 2; ++n) acc[a][b][m][n] = (f32x4){0.f, 0.f, 0.f, 0.f};
        }
        cur = nxt; cA = nA; cB = nB; krC = krN; ++ui;
        if constexpr (ALIGN_EPI) { if (wr == 1) PG8_BAR; }
    }
    PG8_WAIT_V(0);
    if constexpr (!ALIGN_EPI) { if (wr == 0) PG8_BAR; }
    PG8_BAR;
    if constexpr (Epi::AFTER_DRAIN) { E.fused(acc, cur, wr, wc, fr, fq, lds, wid, lane); S.done(cur); }
#undef PG8_SA
#undef PG8_SB
#undef PG8_STAGE
#undef PG8_LDA
#undef PG8_LDB
#undef PG8_MMA
#undef PG8_WAIT_V
#undef PG8_WAIT_L
#undef PG8_BAR
#undef PG8_SCHED
}
}
#define GAS __attribute__((address_space(1)))
#define LAS __attribute__((address_space(3)))
typedef unsigned short bf16;
typedef unsigned v4u __attribute__((ext_vector_type(4)));
typedef float f32x4 __attribute__((ext_vector_type(4)));
typedef short bf16x8 __attribute__((ext_vector_type(8)));
typedef GAS unsigned gu32;
typedef GAS unsigned long long gu64;
#define RLX_AGENT __ATOMIC_RELAXED, __HIP_MEMORY_SCOPE_AGENT
#define LDS_WAIT() asm volatile("s_waitcnt lgkmcnt(0)" ::: "memory")
#define VM_WAIT() asm volatile("s_waitcnt vmcnt(0)" ::: "memory")
__device__ __forceinline__ unsigned long long rt() { return __builtin_amdgcn_s_memrealtime(); }
__device__ __forceinline__ unsigned f2bf(float f) { unsigned u = __builtin_bit_cast(unsigned, f); return (u + 0x7fffu + ((u >> 16) & 1u)) >> 16; }
__device__ __forceinline__ unsigned pk2(float lo, float hi) { return f2bf(lo) | (f2bf(hi) << 16); }
#define XB_TMO      128
#define XB_XCNT(j)  (256  + 64 * (j))
#define XB_XSUB(j)  (1280 + 64 * (j))
#define XB_XGEN(j)  (2304 + 64 * (j))
#define XB_TOP      3328
#define XB_TOPGEN   3392
#define XCD_BAR_WORDS 3456
#define XB_SPIN_CAP (1u << 18)

__device__ __forceinline__ unsigned xb_ld(unsigned* p)              { return __hip_atomic_load(p, __ATOMIC_RELAXED, __HIP_MEMORY_SCOPE_AGENT); }
__device__ __forceinline__ unsigned xb_add(unsigned* p, unsigned v) { return __hip_atomic_fetch_add(p, v, __ATOMIC_RELAXED, __HIP_MEMORY_SCOPE_AGENT); }
__device__ __forceinline__ unsigned xb_xcc_id() { return (unsigned)__builtin_amdgcn_s_getreg((3 << 11) | 20) & 0xFu; }
#define XB_SPIN(cond, bar) do { unsigned _sp = 0; while (cond) { __builtin_amdgcn_s_sleep(1); \
    if ((++_sp & 255u) == 0u) { if (xb_ld(&(bar)[XB_TMO])) break; if (_sp > XB_SPIN_CAP) { atomicAdd(&(bar)[XB_TMO], 1u); break; } } } } while (0)

struct XcdBarrier {
    unsigned* bar; unsigned x;
    volatile LAS unsigned* st;
};

__device__ __forceinline__ XcdBarrier xcd_barrier_post(unsigned* bar, volatile LAS unsigned* st) {
    XcdBarrier b; b.bar = bar; b.x = xb_xcc_id(); b.st = st;
    if (threadIdx.x == 0) (void)xb_add(&bar[XB_XCNT(b.x)], 1u);
    return b;
}
__device__ __forceinline__ void xcd_barrier_complete(unsigned* bar, unsigned x, unsigned& nloc, unsigned& nx) {
    const unsigned G = gridDim.x * gridDim.y * gridDim.z;
    unsigned sum, cnt, mine, sp = 0u;
    for (;;) {
        sum = 0u; cnt = 0u; mine = 0u;
#pragma unroll
        for (unsigned j = 0; j < 16; ++j) { const unsigned c = xb_ld(&bar[XB_XCNT(j)]); sum += c; cnt += (c > 0u) ? 1u : 0u; mine = (j == x) ? c : mine; }
        if (sum == G) break;
        __builtin_amdgcn_s_sleep(1);
        if ((++sp & 255u) == 0u) { if (xb_ld(&bar[XB_TMO])) break; if (sp > XB_SPIN_CAP) { atomicAdd(&bar[XB_TMO], 1u); break; } }
    }
    nloc = mine > 0u ? mine : 1u; nx = cnt > 0u ? cnt : 1u;
}

__device__ __forceinline__ void xcd_barrier(const XcdBarrier& b) {
    asm volatile("s_waitcnt vmcnt(0)" ::: "memory");
    __syncthreads();
    if (threadIdx.x == 0) {
        unsigned* bar = b.bar;
        __builtin_amdgcn_s_waitcnt(0);
        unsigned nloc = b.st[0], nx = b.st[1];
        if (nloc == 0u) { xcd_barrier_complete(bar, b.x, nloc, nx); b.st[0] = nloc; b.st[1] = nx; }
        const unsigned old = xb_add(&bar[XB_XSUB(b.x)], 1u);
        const unsigned gen = old / nloc;
        if (old + 1u == (gen + 1u) * nloc) {
            __builtin_amdgcn_fence(__ATOMIC_RELEASE, "agent");
            asm volatile("s_waitcnt vmcnt(0)" ::: "memory");
            const unsigned og = xb_add(&bar[XB_TOP], 1u);
            const unsigned tg = og / nx;
            if (og + 1u == (tg + 1u) * nx) xb_add(&bar[XB_TOPGEN], 1u);
            else XB_SPIN(xb_ld(&bar[XB_TOPGEN]) == tg, bar);
            __builtin_amdgcn_fence(__ATOMIC_ACQUIRE, "agent");
            xb_add(&bar[XB_XGEN(b.x)], 1u);
            asm volatile("s_waitcnt vmcnt(0)" ::: "memory");
        } else {
            XB_SPIN(xb_ld(&bar[XB_XGEN(b.x)]) == gen, bar);
            __builtin_amdgcn_fence(__ATOMIC_ACQUIRE, "agent");
            asm volatile("s_waitcnt vmcnt(0)" ::: "memory");
        }
    }
    __syncthreads();
}

constexpr int NWAVES = 8;
constexpr int NTOK = 65536, DM = 1024, SEQ = 2048, NBATCH = 32, INC = 4864;
constexpr int NEXP = 32, TOPK = 4;
constexpr int IN_BF = 2048;
constexpr float NORM_EPS = 1e-5f;
constexpr float LOG2E = 1.4426950408889634f;
constexpr float QSCALE = 0.125f * LOG2E;
constexpr int HALF_TOK = NTOK;
constexpr int HALF_ROWS = NTOK * TOPK + NEXP * 256;

constexpr size_t MiB = 1u << 20;
constexpr size_t WS_CTL = 0, CTL_ZERO_BYTES = 1 * MiB;
constexpr int CW_BAR = 4096;
constexpr size_t WS_WIN = 2 * MiB;
constexpr size_t WS_WIN8 = 8 * MiB;
constexpr size_t WS_WUA = 12 * MiB;
constexpr size_t WS_WUH = 13 * MiB;
constexpr size_t WS_WOUT = 14 * MiB;
constexpr size_t WS_W1 = 184 * MiB;
constexpr size_t WS_W2 = 16 * MiB;
constexpr size_t WS_ROPE = 55 * MiB;
constexpr size_t WS_WRT = 55 * MiB + 512 * 1024;
constexpr size_t WS_TOPE = 48 * MiB;
constexpr size_t WS_GATE = 49 * MiB;
constexpr size_t WS_LRANK = 50 * MiB;
constexpr size_t WS_ROWOF = 51 * MiB;
constexpr size_t WS_RS = 54 * MiB + 512 * 1024;
constexpr size_t WS_CNT = 52 * MiB;
constexpr size_t WS_EST = 52 * MiB + 512 * 1024;
constexpr size_t WS_RSROW = 54 * MiB + 768 * 1024;
constexpr size_t WS_GATEROW = 53 * MiB;
constexpr size_t WS_U = 248 * MiB;
constexpr size_t WS_MX = 56 * MiB;
constexpr size_t WS_Z = 376 * MiB;
constexpr size_t WS_Q = WS_Z;
constexpr size_t WS_KV = WS_Z + 64 * MiB;
constexpr size_t WS_HQ = WS_Z + 96 * MiB;
constexpr size_t WS_HF = WS_Z + 160 * MiB;
constexpr size_t WS_HI = WS_Z + 224 * MiB;
constexpr size_t WS_HG = WS_Z + 288 * MiB;
constexpr size_t WS_GA = WS_Z + 352 * MiB;
constexpr size_t WS_GB = WS_Z + 480 * MiB;
constexpr size_t WS_U8 = WS_MX;
constexpr size_t WS_YH = WS_U;
constexpr size_t WS_AO = WS_U + 64 * MiB;
constexpr size_t WS_Y = 184 * MiB;
constexpr size_t WS_XS = 448 * MiB;
constexpr size_t WS_ACT = 712 * MiB;
constexpr size_t WS_END = WS_Z + 608 * MiB;
static_assert((size_t)HALF_ROWS * 2048 == 528 * MiB && WS_Y + 528 * MiB == WS_ACT && WS_XS + 264 * MiB == WS_ACT && WS_XS >= WS_U + 64 * MiB, "MoE buffers");
static_assert(WS_ACT + 264 * MiB <= WS_END && WS_END <= 1024 * MiB && WS_MX + 128 * MiB <= WS_W1 && WS_W1 + 64 * MiB <= WS_U, "ws map");

constexpr int LDS_BYTES = 147456;
constexpr int RING_BYTES = 131072;
constexpr int MISC_OFF = RING_BYTES + 320;

typedef float f32x16 __attribute__((ext_vector_type(16)));
typedef unsigned u32x2 __attribute__((ext_vector_type(2)));

__device__ __forceinline__ float bf2f(unsigned short v) { return __builtin_bit_cast(float, (unsigned)v << 16); }
__device__ __forceinline__ float bflo(unsigned w) { return __builtin_bit_cast(float, w << 16); }
__device__ __forceinline__ float bfhi(unsigned w) { return __builtin_bit_cast(float, w & 0xffff0000u); }
__device__ __forceinline__ float sigmoidf_(float x) { return 1.f / (1.f + __expf(-x)); }
__device__ __forceinline__ float wave_sum(float v) {
#pragma unroll
    for (int o = 1; o < 64; o <<= 1) v += __shfl_xor(v, o);
    return v;
}

__device__ __forceinline__ unsigned pk4_fp8(float a, float b, float c, float d) {
    int w = 0; w = __builtin_amdgcn_cvt_pk_fp8_f32(a, b, w, false); w = __builtin_amdgcn_cvt_pk_fp8_f32(c, d, w, true); return (unsigned)w; }
__device__ __forceinline__ float clamp448(float v) { return fminf(fmaxf(v, -448.f), 448.f); }
struct Args { const float* in[18]; float* out; unsigned char* ws; int ph_lo, ph_hi; };
struct Frame {
    LAS unsigned char* lds;
    int tid, lane, wave, G;
    float* out;
    unsigned char* ws;
};

using pg8::Unit;

struct EpiInProj {
    static constexpr bool PERM = true, AFTER_DRAIN = false;
    unsigned char* ws; const float* bias; const float* rope; int pn_keep, pn_add;
    __device__ __forceinline__ void operator()(const pg8::f32x4 (&acc)[2][2][4][2], const Unit& u, int wr, int wc, int fr, int fq) const {
        const int pn = u.pn + (u.pn >= pn_keep ? pn_add : 0);
        bf16* dst; int ld, c0;
        if (pn < 2) { dst = (bf16*)(ws + WS_Q); ld = 512; c0 = 256 * pn; }
        else if (pn == 2) { dst = (bf16*)(ws + WS_KV); ld = 256; c0 = 0; }
        else if (pn < 11) { const int k = (pn - 3) >> 1; dst = (bf16*)(ws + WS_HQ + (size_t)k * 64 * MiB); ld = 512; c0 = 256 * ((pn - 3) & 1); }
        else { const int k = (pn - 11) >> 2; dst = (bf16*)(ws + WS_GA + (size_t)k * 128 * MiB); ld = 1024; c0 = 256 * ((pn - 11) & 3); }
        const int row0 = u.pm * 256 + wr * 64 + fr;
#pragma unroll
        for (int bj = 0; bj < 2; ++bj) {
            const int cl = bj * 128 + wc * 32 + 8 * fq;
            const int sc = pn * 256 + cl;
            const bool rp = (pn < 2) || (pn == 2 && bj == 0);
            const int hb = sc & ~63, grp = (sc & 63) >> 3;
            pg8::f32x4 b0, b1;
            if (rp) { b0 = *(const pg8::f32x4*)(bias + hb + grp * 4); b1 = *(const pg8::f32x4*)(bias + hb + 32 + grp * 4); }
            else { b0 = *(const pg8::f32x4*)(bias + sc); b1 = *(const pg8::f32x4*)(bias + sc + 4); }
            const float qs = (pn < 2) ? QSCALE : 1.f;
#pragma unroll
            for (int ai = 0; ai < 2; ++ai)
#pragma unroll
                for (int m = 0; m < 4; ++m) {
                    const int row = row0 + ai * 128 + m * 16;
                    pg8::f32x4 v0 = acc[ai][bj][m][0] + b0, v1 = acc[ai][bj][m][1] + b1;
                    if (rp) {
                        const int pos = row & (SEQ - 1);
                        const pg8::f32x4 cs = *(const pg8::f32x4*)(rope + pos * 32 + grp * 4);
                        const pg8::f32x4 sn = *(const pg8::f32x4*)(rope + SEQ * 32 + pos * 32 + grp * 4);
                        const pg8::f32x4 o0 = (v0 * cs - v1 * sn) * qs, o1 = (v1 * cs + v0 * sn) * qs;
                        v0 = o0; v1 = o1;
                    }
                    pg8::u32x4 w; w.x = pg8::cvt_pk_bf16(v0[0], v0[1]); w.y = pg8::cvt_pk_bf16(v0[2], v0[3]); w.z = pg8::cvt_pk_bf16(v1[0], v1[1]); w.w = pg8::cvt_pk_bf16(v1[2], v1[3]);
                    *(pg8::u32x4*)(dst + (size_t)row * ld + c0 + cl) = w;
                }
        }
    }
};

struct EpiFuse {
    static constexpr bool PERM = true, AFTER_DRAIN = false;
    const bf16* Ga; bf16* Gb; unsigned char* M8;
    __device__ __forceinline__ void mid(pg8::f32x4 (&acc)[2][2][4][2], const Unit& u, int wr, int wc, int fr, int fq) const {
        const int row0 = u.pm * 256 + wr * 64 + fr;
#pragma unroll
        for (int ai = 0; ai < 2; ++ai)
#pragma unroll
            for (int m = 0; m < 4; ++m)
#pragma unroll
                for (int bj = 0; bj < 2; ++bj) {
                    const size_t off = (size_t)(row0 + ai * 128 + m * 16) * 1024 + u.pn * 256 + bj * 128 + wc * 32 + 8 * fq;
                    const pg8::u32x4 av = *(const pg8::u32x4*)(Ga + off), hv = *(const pg8::u32x4*)(Gb + off);
#pragma unroll
                    for (int i = 0; i < 4; ++i) {
                        const float a0 = bflo(av[i]), a1 = bfhi(av[i]), h0 = fmaxf(bflo(hv[i]), -60.f), h1 = fmaxf(bfhi(hv[i]), -60.f);
                        const float r0 = (1.f + __expf(-h0)) * __builtin_amdgcn_rcpf(1.f + __expf(-a0)), r1 = (1.f + __expf(-h1)) * __builtin_amdgcn_rcpf(1.f + __expf(-a1));
                        acc[ai][bj][m][i >> 1][(i & 1) * 2] *= r0; acc[ai][bj][m][i >> 1][(i & 1) * 2 + 1] *= r1;
                    }
                }
    }
    __device__ __forceinline__ void operator()(const pg8::f32x4 (&acc)[2][2][4][2], const Unit& u, int wr, int wc, int fr, int fq) const {
        const int row0 = u.pm * 256 + wr * 64 + fr;
#pragma unroll
        for (int ai = 0; ai < 2; ++ai)
#pragma unroll
            for (int m = 0; m < 4; ++m)
#pragma unroll
                for (int bj = 0; bj < 2; ++bj) {
                    const size_t off = (size_t)(row0 + ai * 128 + m * 16) * 1024 + u.pn * 256 + bj * 128 + wc * 32 + 8 * fq;
                    const pg8::u32x4 hv = *(const pg8::u32x4*)(Gb + off);
                    float o[8];
#pragma unroll
                    for (int i = 0; i < 4; ++i) {
                        const float h0 = fmaxf(bflo(hv[i]), -60.f), h1 = fmaxf(bfhi(hv[i]), -60.f);
                        const pg8::f32x4 a = acc[ai][bj][m][i >> 1];
                        o[2 * i] = a[(i & 1) * 2] * __builtin_amdgcn_rcpf(1.f + __expf(-h0)); o[2 * i + 1] = a[(i & 1) * 2 + 1] * __builtin_amdgcn_rcpf(1.f + __expf(-h1));
                    }
                    u32x2 w; w.x = pk4_fp8(clamp448(8.f * o[0]), clamp448(8.f * o[1]), clamp448(8.f * o[2]), clamp448(8.f * o[3])); w.y = pk4_fp8(clamp448(8.f * o[4]), clamp448(8.f * o[5]), clamp448(8.f * o[6]), clamp448(8.f * o[7]));
                    *(u32x2*)(M8 + off) = w;
                }
    }
};

struct EpiPlain {
    static constexpr bool PERM = true, AFTER_DRAIN = false;
    bf16* O;
    __device__ __forceinline__ void operator()(const pg8::f32x4 (&acc)[2][2][4][2], const Unit& u, int wr, int wc, int fr, int fq) const {
        const int row0 = u.pm * 256 + wr * 64 + fr;
#pragma unroll
        for (int ai = 0; ai < 2; ++ai)
#pragma unroll
            for (int m = 0; m < 4; ++m)
#pragma unroll
                for (int bj = 0; bj < 2; ++bj) {
                    const pg8::f32x4 v0 = acc[ai][bj][m][0], v1 = acc[ai][bj][m][1];
                    pg8::u32x4 w; w.x = pg8::cvt_pk_bf16(v0[0], v0[1]); w.y = pg8::cvt_pk_bf16(v0[2], v0[3]); w.z = pg8::cvt_pk_bf16(v1[0], v1[1]); w.w = pg8::cvt_pk_bf16(v1[2], v1[3]);
                    *(pg8::u32x4*)(O + (size_t)(row0 + ai * 128 + m * 16) * 1024 + u.pn * 256 + bj * 128 + wc * 32 + 8 * fq) = w;
                }
    }
};

struct EpiSwiGlu {
    static constexpr bool PERM = true, AFTER_DRAIN = false;
    unsigned char* act; const float* b1;
    __device__ __forceinline__ void operator()(const pg8::f32x4 (&acc)[2][2][4][2], const Unit& u, int wr, int wc, int fr, int fq) const {
        const int e = u.pn >> 3, ct = u.pn & 7;
        const int j0 = 128 * ct + 32 * wc + 8 * fq;
        const float* bp = b1 + (size_t)e * 2048 + j0;
        const pg8::f32x4 bg0 = *(const pg8::f32x4*)(bp), bg1 = *(const pg8::f32x4*)(bp + 4), bl0 = *(const pg8::f32x4*)(bp + 1024), bl1 = *(const pg8::f32x4*)(bp + 1028);
        const int row0 = u.pm * 256 + wr * 64 + fr;
#pragma unroll
        for (int ai = 0; ai < 2; ++ai)
#pragma unroll
            for (int m = 0; m < 4; ++m) {
                const int row = row0 + ai * 128 + m * 16;
                float o[8];
#pragma unroll
                for (int n = 0; n < 2; ++n) {
                    const pg8::f32x4 g = acc[ai][0][m][n] + (n ? bg1 : bg0), l = acc[ai][1][m][n] + (n ? bl1 : bl0);
#pragma unroll
                    for (int i = 0; i < 4; ++i) {
                        const float gg = fminf(g[i], 7.f), ll = fminf(fmaxf(l[i], -7.f), 7.f);
                        o[4 * n + i] = gg * __builtin_amdgcn_rcpf(1.f + __expf(-1.702f * gg)) * (ll + 1.f);
                    }
                }
                u32x2 w; w.x = pk4_fp8(o[0], o[1], o[2], o[3]); w.y = pk4_fp8(o[4], o[5], o[6], o[7]);
                *(u32x2*)(act + (size_t)row * 1024 + j0) = w;
            }
    }
};

struct EpiMoeOut {
    static constexpr bool PERM = true, AFTER_DRAIN = false;
    unsigned char* y; const float* b2; const float* gaterow;
    __device__ __forceinline__ void operator()(const pg8::f32x4 (&acc)[2][2][4][2], const Unit& u, int wr, int wc, int fr, int fq) const {
        const int e = u.pn >> 2, ct = u.pn & 3;
        const int row0 = u.pm * 256 + wr * 64 + fr;
#pragma unroll
        for (int bj = 0; bj < 2; ++bj) {
            const int col = 256 * ct + 128 * bj + 32 * wc + 8 * fq;
            const pg8::f32x4 b0 = *(const pg8::f32x4*)(b2 + (size_t)e * 1024 + col), bb1 = *(const pg8::f32x4*)(b2 + (size_t)e * 1024 + col + 4);
#pragma unroll
            for (int ai = 0; ai < 2; ++ai)
#pragma unroll
                for (int m = 0; m < 4; ++m) {
                    const int row = row0 + ai * 128 + m * 16;
                    const float gt = 16.f * gaterow[row];
                    const pg8::f32x4 v0 = (acc[ai][bj][m][0] + b0) * gt, v1 = (acc[ai][bj][m][1] + bb1) * gt;
                    u32x2 w; w.x = pk4_fp8(clamp448(v0[0]), clamp448(v0[1]), clamp448(v0[2]), clamp448(v0[3])); w.y = pk4_fp8(clamp448(v1[0]), clamp448(v1[1]), clamp448(v1[2]), clamp448(v1[3]));
                    *(u32x2*)(y + (size_t)row * 1024 + col) = w;
                }
        }
    }
};

struct MoeOrder {
    unsigned pk[16]; int ntiles, sh, c, G;
    __device__ __forceinline__ void init(const int* est, int lane, int nct_shift, int G_, int c_) {
        const int v = est[lane & 63];
        int st[33];
#pragma unroll
        for (int k = 0; k < 33; ++k) st[k] = __builtin_amdgcn_readlane(v, k);
#pragma unroll
        for (int k = 0; k < 16; ++k) pk[k] = (unsigned)st[2 * k] | ((unsigned)st[2 * k + 1] << 16);
        ntiles = st[32]; sh = nct_shift; G = G_; c = (G_ % 8 == 0) ? (c_ % 8) * (G_ / 8) + c_ / 8 : c_;
    }
    __device__ __forceinline__ bool next(int i, Unit& u) const {
        const int uid = i * G + c, rt = uid >> sh, ct = uid & ((1 << sh) - 1);
        if (rt >= ntiles) return false;
        int e = 0;
#pragma unroll
        for (int k = 1; k < 32; ++k) e += (rt >= (int)((pk[k >> 1] >> (16 * (k & 1))) & 0xffffu)) ? 1 : 0;
        u.pm = rt; u.pn = (e << sh) + ct; return true;
    }
    __device__ __forceinline__ int krot(const Unit& u, int nt) const { const int ct = u.pn & ((1 << sh) - 1); return (2 * (ct + (sh == 3 ? u.pm : (u.pm >> 1)))) & (nt - 1); }
    __device__ __forceinline__ void a_ready(const Unit&) const {}
    __device__ __forceinline__ void done(const Unit&) const {}
};

template <class RowMap>
__device__ __forceinline__ void transpose_item(const float* W, int K, int N, bf16* WT, const RowMap& rm, LAS float* scr, int item, int lane) {
    const int nblk = N / 32, kb = item / nblk, nb = item % nblk, k0 = 64 * kb, n0 = 32 * nb;
#pragma unroll 8
    for (int i = 0; i < 32; ++i) { const int kk = 2 * i + (lane >> 5); scr[kk * 33 + (lane & 31)] = W[(size_t)(k0 + kk) * N + n0 + (lane & 31)]; }
    LDS_WAIT(); asm volatile("" ::: "memory");
    const int c = lane & 7;
#pragma unroll
    for (int j = 0; j < 4; ++j) { const int n = (lane >> 3) + 8 * j; const LAS float* s = scr + (8 * c) * 33 + n;
        v4u o; o.x = pk2(s[0 * 33], s[1 * 33]); o.y = pk2(s[2 * 33], s[3 * 33]); o.z = pk2(s[4 * 33], s[5 * 33]); o.w = pk2(s[6 * 33], s[7 * 33]);
        *(GAS v4u*)(WT + (size_t)rm(n0 + n) * K + k0 + 8 * c) = o; }
    LDS_WAIT(); asm volatile("" ::: "memory");
}
template <class RowMap>
__device__ __forceinline__ void transpose_item_f8(const float* W, int K, int N, unsigned char* WT, const RowMap& rm, LAS float* scr, int item, int lane) {
    const int nblk = N / 32, kb = item / nblk, nb = item % nblk, k0 = 64 * kb, n0 = 32 * nb;
#pragma unroll 8
    for (int i = 0; i < 32; ++i) { const int kk = 2 * i + (lane >> 5); scr[kk * 33 + (lane & 31)] = W[(size_t)(k0 + kk) * N + n0 + (lane & 31)]; }
    LDS_WAIT(); asm volatile("" ::: "memory");
    const int c = lane & 7;
#pragma unroll
    for (int j = 0; j < 4; ++j) { const int n = (lane >> 3) + 8 * j; const LAS float* s = scr + (8 * c) * 33 + n;
        u32x2 o; o.x = pk4_fp8(32.f * s[0 * 33], 32.f * s[1 * 33], 32.f * s[2 * 33], 32.f * s[3 * 33]); o.y = pk4_fp8(32.f * s[4 * 33], 32.f * s[5 * 33], 32.f * s[6 * 33], 32.f * s[7 * 33]);
        *(GAS u32x2*)(WT + (size_t)rm(n0 + n) * K + k0 + 8 * c) = o; }
    LDS_WAIT(); asm volatile("" ::: "memory");
}
struct RmId { __device__ __forceinline__ int operator()(int n) const { return n; } };
struct RmIn {
    __device__ __forceinline__ int operator()(int n) const {
        if (n >= 640) return n;
        const int hb = n & ~63, d = n & 63, half = d >> 5, grp = (d & 31) >> 2, j = d & 3;
        return hb + grp * 8 + half * 4 + j;
    }
};
struct RmW1 {
    __device__ __forceinline__ int operator()(int n) const { const int lin = n >> 10, j = n & 1023; return (j >> 7) * 256 + lin * 128 + (j & 127); }
};

__device__ __forceinline__ void p0_prologue(Frame& F, const Args& A) {
    LAS float* scr = (LAS float*)(F.lds + F.wave * 16384);
    const int gw = blockIdx.x * NWAVES + F.wave, NGW = F.G * NWAVES;
    unsigned char* ws = F.ws;
    constexpr int I_IN = 16 * (INC / 32), I_UA = 8 * 32, I_OUT = 16 * 32, I_W1 = 16 * 64, I_W2 = 16 * 32;
    constexpr int NITEMS = I_IN + 2 * I_UA + I_OUT;
    for (int it = gw; it < NITEMS; it += NGW) {
        int r = it;
        if (r < I_IN) { const int nb_ = r % (INC / 32), n0_ = 32 * nb_;
            if (n0_ >= 768 && n0_ < 2816) transpose_item(A.in[2], 1024, INC, (bf16*)(ws + WS_WIN) - (size_t)768 * 1024, RmIn(), scr, r, F.lane);
            else if (n0_ < 768) transpose_item_f8(A.in[2], 1024, INC, ws + WS_WIN8, RmIn(), scr, r, F.lane);
            else transpose_item_f8(A.in[2], 1024, INC, ws + WS_WIN8 - (size_t)2048 * 1024, RmId(), scr, r, F.lane);
            continue; } r -= I_IN;
        if (r < I_UA) { transpose_item(A.in[7], 512, 1024, (bf16*)(ws + WS_WUA), RmId(), scr, r, F.lane); continue; } r -= I_UA;
        if (r < I_UA) { transpose_item(A.in[8], 512, 1024, (bf16*)(ws + WS_WUH), RmId(), scr, r, F.lane); continue; } r -= I_UA;
        transpose_item_f8(A.in[9], 1024, 1024, ws + WS_WOUT, RmId(), scr, r, F.lane);
    }
    const int gt = blockIdx.x * (NWAVES * 64) + F.tid, NGT = F.G * NWAVES * 64;
    { bf16* wh = (bf16*)(ws + WS_WRT); bf16* wl = wh + 32 * 1024;
      for (int i = gt; i < 32 * 1024; i += NGT) { const int e = i >> 10, k = i & 1023; const float v = A.in[10][k] * A.in[11][k * 32 + e];
          const unsigned h = f2bf(v); const float r = v - bf2f((unsigned short)h); wh[i] = (bf16)h; wl[i] = (bf16)f2bf(r); } }
    { float* rc = (float*)(ws + WS_ROPE); float* rsn = rc + SEQ * 32;
      for (int i = gt; i < SEQ * 32; i += NGT) { const int pos = i >> 5, j = i & 31;
          const float inv = (float)pow(10000.0, -(double)j / 32.0); const float ang = (float)pos * inv;
          rc[i] = (float)cos((double)ang); rsn[i] = (float)sin((double)ang); } }
    { const float* x = A.in[0]; const float* g = A.in[1]; bf16* U = (bf16*)(ws + WS_U);
      f32x4 gv[4];
#pragma unroll
      for (int j = 0; j < 4; ++j) gv[j] = *(const f32x4*)(g + 256 * j + 4 * F.lane);
      for (int m0 = gw * 4; m0 < NTOK; m0 += NGW * 4) {
          f32x4 v[4][4]; float s[4];
#pragma unroll
          for (int r = 0; r < 4; ++r) { const GAS f32x4* xr = (const GAS f32x4*)(x + (size_t)(m0 + r) * DM) + F.lane;
#pragma unroll
              for (int j = 0; j < 4; ++j) v[r][j] = __builtin_nontemporal_load((const f32x4*)(x + (size_t)(m0 + r) * DM) + F.lane + 64 * j); }
#pragma unroll
          for (int r = 0; r < 4; ++r) { float t = 0.f;
#pragma unroll
              for (int j = 0; j < 4; ++j) t += (v[r][j].x * v[r][j].x + v[r][j].y * v[r][j].y) + (v[r][j].z * v[r][j].z + v[r][j].w * v[r][j].w);
              s[r] = t; }
#pragma unroll
          for (int o = 1; o < 64; o <<= 1) {
#pragma unroll
              for (int r = 0; r < 4; ++r) s[r] += __shfl_xor(s[r], o); }
#pragma unroll
          for (int r = 0; r < 4; ++r) { const float rs = rsqrtf(s[r] * (1.f / DM) + NORM_EPS);
              GAS unsigned long long* o8 = (GAS unsigned long long*)(U + (size_t)(m0 + r) * DM) + F.lane;
#pragma unroll
              for (int j = 0; j < 4; ++j) { const f32x4 t = v[r][j] * rs * gv[j]; o8[64 * j] = (unsigned long long)pk2(t.x, t.y) | ((unsigned long long)pk2(t.z, t.w) << 32);
                  *(GAS unsigned*)(ws + WS_U8 + (size_t)(m0 + r) * DM + 256 * j + 4 * F.lane) = pk4_fp8(clamp448(t.x), clamp448(t.y), clamp448(t.z), clamp448(t.w)); } }
      } }
}

constexpr int WP_I1 = 32 * 8, WP_I2 = 32 * 4, WP_NIT = NEXP * (WP_I1 + WP_I2);
constexpr int WP_SPLIT = (WP_NIT * 6 / 10) / 2048 * 2048;
__device__ __forceinline__ void moe_weight_prep(Frame& F, const Args& A, int wg0, int nwg, int it0, int it1) {
    unsigned char* ws = F.ws;
    const int lane = F.lane;
    const int gw = ((int)blockIdx.x - wg0) * NWAVES + F.wave, NGW = nwg * NWAVES;
    for (int it = it0 + gw; it < it1; it += NGW) {
        const bool isw1 = it < NEXP * WP_I1;
        const int r = isw1 ? it : it - NEXP * WP_I1;
        const int per = isw1 ? WP_I1 : WP_I2, e = r / per, rr = r % per, kb = rr & 31, nb = rr >> 5, N = isw1 ? 2048 : 1024;
        const float* W = (isw1 ? A.in[13] + (size_t)e * 1024 * 2048 : A.in[15] + (size_t)e * 1024 * 1024) + (size_t)(32 * kb) * N + 256 * nb + 4 * lane;
        f32x4 v[32];
#pragma unroll
        for (int j = 0; j < 32; ++j) v[j] = __builtin_nontemporal_load((const f32x4*)(W + (size_t)j * N));
        unsigned char* WT = isw1 ? ws + WS_W1 + (size_t)e * 2048 * 1024 : ws + WS_W2 + (size_t)e * 1024 * 1024;
#pragma unroll
        for (int c = 0; c < 4; ++c) { const int n = 256 * nb + 4 * lane + c; const int drow = isw1 ? RmW1()(n) : n;
            v4u o0, o1;
#pragma unroll
            for (int q = 0; q < 4; ++q) { o0[q] = pk4_fp8(32.f * v[4 * q][c], 32.f * v[4 * q + 1][c], 32.f * v[4 * q + 2][c], 32.f * v[4 * q + 3][c]);
                                          o1[q] = pk4_fp8(32.f * v[16 + 4 * q][c], 32.f * v[16 + 4 * q + 1][c], 32.f * v[16 + 4 * q + 2][c], 32.f * v[16 + 4 * q + 3][c]); }
            *(GAS v4u*)(WT + (size_t)drow * 1024 + 32 * kb) = o0; *(GAS v4u*)(WT + (size_t)drow * 1024 + 32 * kb + 16) = o1; }
    }
}

typedef short s16x4 __attribute__((ext_vector_type(4)));
typedef short v4i16_t __attribute__((ext_vector_type(4)));
__device__ __forceinline__ s16x4 ldtr(const LAS unsigned char* p) { return __builtin_bit_cast(s16x4, __builtin_amdgcn_ds_read_tr16_b64_v4i16((LAS v4i16_t*)p)); }
typedef float f32x2_t __attribute__((ext_vector_type(2))); typedef __bf16 bf16x2_t __attribute__((ext_vector_type(2)));
__device__ __forceinline__ unsigned cvtpk(float lo, float hi) { f32x2_t v = {lo, hi}; bf16x2_t b = __builtin_convertvector(v, bf16x2_t); return __builtin_bit_cast(unsigned, b); }
__device__ __forceinline__ void attn_phase(Frame& F, const Args& A, int wg0, int nwg) {
    const bf16* Q = (const bf16*)(F.ws + WS_Q); const bf16* KV = (const bf16*)(F.ws + WS_KV); bf16* AO = (bf16*)(F.ws + WS_AO);
    const float* sinks = A.in[4];
    const int lane = F.lane, r32 = lane & 31, hi = lane >> 5;
    LAS unsigned char* vs = F.lds + F.wave * 8192;
    const LAS unsigned char* vp = vs + ((lane >> 4) & 1) * 32 + (lane & 3) * 8 + (4 * hi + ((lane & 15) >> 2)) * 64;
    LAS unsigned char* qs = F.lds + 65536 + F.wave * 8192 + lane * 16;
    const int gw = ((int)blockIdx.x - wg0) * NWAVES + F.wave, NGW = nwg * NWAVES;
    constexpr int NUNITS = NBATCH * 2 * 2 * 64;
#define AT_DEC(u_, b_, kvh_, h_, q0_) do { b_ = (u_) >> 8; const int rem_ = (u_) & 255; kvh_ = rem_ >> 7; h_ = kvh_ * 4 + 2 * ((rem_ >> 6) & 1); q0_ = (rem_ & 63) * 32; } while (0)
#define AT_TF(q0_) ((((q0_) - 127) >> 6) < 0 ? 0 : (((q0_) - 127) >> 6))
#define AT_LOADK(KF, b_, kvh_, key0_) do { const bf16* kp_ = KV + ((size_t)(b_) * SEQ + (key0_) + r32) * 256 + (kvh_) * 64 + hi * 8; \
        _Pragma("unroll") for (int d0 = 0; d0 < 4; ++d0) { KF[2 * d0] = *(const bf16x8*)(kp_ + d0 * 16); KF[2 * d0 + 1] = *(const bf16x8*)(kp_ + 32 * 256 + d0 * 16); } } while (0)
#define AT_LOADV(VV, b_, kvh_, key0_) do { \
        _Pragma("unroll") for (int p = 0; p < 8; ++p) VV[p] = *(const v4u*)(KV + ((size_t)(b_) * SEQ + (key0_) + 16 * (p & 3) + (lane >> 2)) * 256 + 128 + (kvh_) * 64 + 32 * (p >> 2) + 8 * (lane & 3)); } while (0)
#define AT_LOADQ(HD, b_, h_, q0_) do { _Pragma("unroll") for (int d0 = 0; d0 < 4; ++d0) *(LAS bf16x8*)(qs + ((HD) * 4 + d0) * 1024) = *(const bf16x8*)(Q + ((size_t)(b_) * SEQ + (q0_) + r32) * 512 + (h_) * 64 + d0 * 16 + hi * 8); } while (0)
#define AT_Q(HD, d0) (*(const LAS bf16x8*)(qs + ((HD) * 4 + (d0)) * 1024))
#define AT_HEAD(HD, M_, L_, O0, O1) do { \
        f32x16 p0, p1; \
        _Pragma("unroll") for (int r = 0; r < 16; ++r) { p0[r] = 0.f; p1[r] = 0.f; } \
        _Pragma("unroll") for (int d0 = 0; d0 < 4; ++d0) { const bf16x8 qf = AT_Q(HD, d0); p0 = __builtin_amdgcn_mfma_f32_32x32x16_bf16(kfN[2 * d0], qf, p0, 0, 0, 0); p1 = __builtin_amdgcn_mfma_f32_32x32x16_bf16(kfN[2 * d0 + 1], qf, p1, 0, 0, 0); } \
        float mx = -INFINITY; \
        if (edge) { const int dq = q - key0 - 4 * hi; _Pragma("unroll") for (int r = 0; r < 16; ++r) { const int c_ = (r & 3) + 8 * (r >> 2); \
            if ((unsigned)(dq - c_) > 127u) p0[r] = -INFINITY; \
            if ((unsigned)(dq - c_ - 32) > 127u) p1[r] = -INFINITY; } } \
        _Pragma("unroll") for (int r = 0; r < 16; ++r) mx = fmaxf(mx, fmaxf(p0[r], p1[r])); \
        mx = fmaxf(mx, __shfl_xor(mx, 32)); \
        const float mn = fmaxf(M_, mx), al = __builtin_amdgcn_exp2f(M_ - mn); M_ = mn; \
        float sum = 0.f; \
        _Pragma("unroll") for (int r = 0; r < 16; ++r) { p0[r] = __builtin_amdgcn_exp2f(p0[r] - mn); p1[r] = __builtin_amdgcn_exp2f(p1[r] - mn); sum += p0[r] + p1[r]; O0[r] *= al; O1[r] *= al; } \
        L_ = L_ * al + sum; \
        bf16x8 pa[4]; \
        _Pragma("unroll") for (int ks = 0; ks < 4; ++ks) { v4u w; \
            _Pragma("unroll") for (int i = 0; i < 4; ++i) w[i] = (ks < 2) ? cvtpk(p0[8 * (ks & 1) + 2 * i], p0[8 * (ks & 1) + 2 * i + 1]) : cvtpk(p1[8 * (ks & 1) + 2 * i], p1[8 * (ks & 1) + 2 * i + 1]); \
            pa[ks] = __builtin_bit_cast(bf16x8, w); } \
        _Pragma("unroll") for (int ks = 0; ks < 4; ++ks) { \
            const s16x4 a0 = ldtr(vp + ks * 1024), a1 = ldtr(vp + ks * 1024 + 512), c0 = ldtr(vp + 4096 + ks * 1024), c1 = ldtr(vp + 4096 + ks * 1024 + 512); \
            const bf16x8 v0 = {a0[0], a0[1], a0[2], a0[3], a1[0], a1[1], a1[2], a1[3]}, v1 = {c0[0], c0[1], c0[2], c0[3], c1[0], c1[1], c1[2], c1[3]}; \
            O0 = __builtin_amdgcn_mfma_f32_32x32x16_bf16(v0, pa[ks], O0, 0, 0, 0); \
            O1 = __builtin_amdgcn_mfma_f32_32x32x16_bf16(v1, pa[ks], O1, 0, 0, 0); } } while (0)
#define AT_STORE(H_, L_, O0, O1) do { const float lt = L_ + __shfl_xor(L_, 32), il = 1.f / lt; \
        bf16* op = AO + ((size_t)b * SEQ + q) * 512 + (H_) * 64 + 4 * hi; \
        _Pragma("unroll") for (int rg = 0; rg < 4; ++rg) { u32x2 w0, w1; \
            w0.x = cvtpk(O0[4 * rg] * il, O0[4 * rg + 1] * il); w0.y = cvtpk(O0[4 * rg + 2] * il, O0[4 * rg + 3] * il); \
            w1.x = cvtpk(O1[4 * rg] * il, O1[4 * rg + 1] * il); w1.y = cvtpk(O1[4 * rg + 2] * il, O1[4 * rg + 3] * il); \
            *(u32x2*)(op + 8 * rg) = w0; *(u32x2*)(op + 32 + 8 * rg) = w1; } } while (0)
    int u = gw;
    if (u >= NUNITS) return;
    int b, kvh, h, q0; AT_DEC(u, b, kvh, h, q0);
    int t = AT_TF(q0);
    bf16x8 kfN[8]; v4u vvN[8];
    AT_LOADK(kfN, b, kvh, 64 * t); AT_LOADV(vvN, b, kvh, 64 * t);
    bool first = true;
    float ma = 0.f, la = 0.f, mb = 0.f, lb = 0.f; f32x16 oa0, oa1, ob0, ob1;
#pragma unroll
    for (int r = 0; r < 16; ++r) { oa0[r] = 0.f; oa1[r] = 0.f; ob0[r] = 0.f; ob1[r] = 0.f; }
    for (;;) {
        const int tlast = (q0 + 31) >> 6, q = q0 + r32, key0 = 64 * t;
        const bool lastt = (t == tlast);
        const bool edge = lastt || (key0 + 127 < q0 + 31);
        if (first) {
            AT_LOADQ(0, b, h, q0); AT_LOADQ(1, b, h + 1, q0);
            ma = sinks[h] * LOG2E; mb = sinks[h + 1] * LOG2E; la = hi ? 0.f : 1.f; lb = la;
#pragma unroll
            for (int r = 0; r < 16; ++r) { oa0[r] = 0.f; oa1[r] = 0.f; ob0[r] = 0.f; ob1[r] = 0.f; }
            first = false;
        }
#pragma unroll
        for (int p = 0; p < 8; ++p) *(LAS v4u*)(vs + p * 1024 + lane * 16) = vvN[p];
        int un = lastt ? u + NGW : u, bn = b, kvhn = kvh, hn = h, q0n = q0;
        const bool more = un < NUNITS;
        int tn = t + 1;
        if (more && lastt) { AT_DEC(un, bn, kvhn, hn, q0n); tn = AT_TF(q0n); }
        if (more) AT_LOADV(vvN, bn, kvhn, 64 * tn);
        AT_HEAD(0, ma, la, oa0, oa1);
        {
            f32x16 p0, p1;
#pragma unroll
            for (int r = 0; r < 16; ++r) { p0[r] = 0.f; p1[r] = 0.f; }
#pragma unroll
            for (int d0 = 0; d0 < 4; ++d0) { const bf16x8 qf = AT_Q(1, d0); p0 = __builtin_amdgcn_mfma_f32_32x32x16_bf16(kfN[2 * d0], qf, p0, 0, 0, 0); p1 = __builtin_amdgcn_mfma_f32_32x32x16_bf16(kfN[2 * d0 + 1], qf, p1, 0, 0, 0); }
            asm volatile("" : "+v"(p0), "+v"(p1));
            if (more) AT_LOADK(kfN, bn, kvhn, 64 * tn);
            float mx = -INFINITY;
            if (edge) { const int dq = q - key0 - 4 * hi;
#pragma unroll
                for (int r = 0; r < 16; ++r) { const int c_ = (r & 3) + 8 * (r >> 2);
                    if ((unsigned)(dq - c_) > 127u) p0[r] = -INFINITY;
                    if ((unsigned)(dq - c_ - 32) > 127u) p1[r] = -INFINITY; } }
#pragma unroll
            for (int r = 0; r < 16; ++r) mx = fmaxf(mx, fmaxf(p0[r], p1[r]));
            mx = fmaxf(mx, __shfl_xor(mx, 32));
            const float mn = fmaxf(mb, mx), al = __builtin_amdgcn_exp2f(mb - mn); mb = mn;
            float sum = 0.f;
#pragma unroll
            for (int r = 0; r < 16; ++r) { p0[r] = __builtin_amdgcn_exp2f(p0[r] - mn); p1[r] = __builtin_amdgcn_exp2f(p1[r] - mn); sum += p0[r] + p1[r]; ob0[r] *= al; ob1[r] *= al; }
            lb = lb * al + sum;
            bf16x8 pa[4];
#pragma unroll
            for (int ks = 0; ks < 4; ++ks) { v4u w;
#pragma unroll
                for (int i = 0; i < 4; ++i) w[i] = (ks < 2) ? cvtpk(p0[8 * (ks & 1) + 2 * i], p0[8 * (ks & 1) + 2 * i + 1]) : cvtpk(p1[8 * (ks & 1) + 2 * i], p1[8 * (ks & 1) + 2 * i + 1]);
                pa[ks] = __builtin_bit_cast(bf16x8, w); }
#pragma unroll
            for (int ks = 0; ks < 4; ++ks) {
                const s16x4 a0 = ldtr(vp + ks * 1024), a1 = ldtr(vp + ks * 1024 + 512), c0 = ldtr(vp + 4096 + ks * 1024), c1 = ldtr(vp + 4096 + ks * 1024 + 512);
                const bf16x8 v0 = {a0[0], a0[1], a0[2], a0[3], a1[0], a1[1], a1[2], a1[3]}, v1 = {c0[0], c0[1], c0[2], c0[3], c1[0], c1[1], c1[2], c1[3]};
                ob0 = __builtin_amdgcn_mfma_f32_32x32x16_bf16(v0, pa[ks], ob0, 0, 0, 0);
                ob1 = __builtin_amdgcn_mfma_f32_32x32x16_bf16(v1, pa[ks], ob1, 0, 0, 0);
            }
        }
        if (lastt) {
            AT_STORE(h, la, oa0, oa1); AT_STORE(h + 1, lb, ob0, ob1);
            if (!more) break;
            u = un; b = bn; kvh = kvhn; h = hn; q0 = q0n; t = tn; first = true;
        } else { t = tn; }
    }
#undef AT_DEC
#undef AT_TF
#undef AT_LOADK
#undef AT_LOADV
#undef AT_LOADQ
#undef AT_Q
#undef AT_HEAD
#undef AT_STORE
}

__device__ __forceinline__ pg8::f32x4 mfma16(bf16x8 a, bf16x8 b, pg8::f32x4 c) { return __builtin_amdgcn_mfma_f32_16x16x32_bf16(a, b, c, 0, 0, 0); }
constexpr int HS_Q = 272, HS_V = 288;
constexpr int HL_QP = 0, HL_KP = 32 * HS_Q, HL_KPP = 2 * 32 * HS_Q, HL_VV = HL_KPP + 32 * HS_V, HL_EREF = HL_VV + 32 * HS_V, HL_DEC = HL_EREF + 512, HL_GSUM = HL_DEC + 512, HL_SSQ = HL_GSUM + 4096;
__device__ __forceinline__ float fsig(float x) { return __builtin_amdgcn_rcpf(1.f + __expf(-x)); }
struct HgStage { unsigned rf[4], rq[4]; v4u rv; u32x2 h0, h1; };
__device__ __forceinline__ void hgrn_phase(Frame& F, const Args& A, int wg0, int nwg) {
    const bf16* HQ = (const bf16*)(F.ws + WS_HQ); const bf16* HFp = (const bf16*)(F.ws + WS_HF); const bf16* HI = (const bf16*)(F.ws + WS_HI); const bf16* HG = (const bf16*)(F.ws + WS_HG);
    bf16* YH = (bf16*)(F.ws + WS_YH);
    LAS unsigned char* L = F.lds;
    const int w = F.wave, lane = F.lane, g = lane >> 4, c16 = lane & 15, qd = c16 >> 2, pd = c16 & 3;
    const int cp = F.tid & 63, tq = F.tid >> 6, tv = F.tid >> 4, cv = F.tid & 15;
    for (int unit = (int)blockIdx.x - wg0; unit < 128; unit += nwg) {
        const int b = unit >> 2, hh = unit & 3; const size_t T0 = (size_t)b * SEQ;
        float lb0, lb1;
        { const float a00 = A.in[5][hh * 128 + 2 * cp], a01 = A.in[5][hh * 128 + 2 * cp + 1], a10 = A.in[5][512 + hh * 128 + 2 * cp], a11 = A.in[5][512 + hh * 128 + 2 * cp + 1];
          lb0 = 1.f / (1.f + __expf(a10 - a00)); lb1 = 1.f / (1.f + __expf(a11 - a01)); }
        const pg8::f32x4 gn = *(const pg8::f32x4*)(A.in[6] + hh * 128 + 16 * w + 4 * g);
        pg8::f32x4 st[8];
#pragma unroll
        for (int i = 0; i < 8; ++i) st[i] = (pg8::f32x4){0.f, 0.f, 0.f, 0.f};
#define HG_LOAD(S, cc) do { const size_t r0_ = T0 + 32 * (size_t)(cc); \
            _Pragma("unroll") for (int i = 0; i < 4; ++i) { const size_t off = (r0_ + 4 * tq + i) * 512 + hh * 128 + 2 * cp; S.rf[i] = __builtin_nontemporal_load((const unsigned*)(HFp + off)); S.rq[i] = __builtin_nontemporal_load((const unsigned*)(HQ + off)); } \
            S.rv = __builtin_nontemporal_load((const v4u*)(HI + (r0_ + tv) * 512 + hh * 128 + cv * 8)); \
            { const size_t o_ = (r0_ + c16) * 512 + hh * 128 + 16 * w + 4 * g; S.h0 = __builtin_nontemporal_load((const u32x2*)(HG + o_)); S.h1 = __builtin_nontemporal_load((const u32x2*)(HG + o_ + 16 * 512)); } } while (0)
#define HG_FIN(prow0) do { float t0 = 0.f, t1 = 0.f; \
              _Pragma("unroll") for (int ww = 0; ww < 8; ++ww) { t0 += ((const LAS float*)(L + HL_SSQ))[ww * 32 + c16]; t1 += ((const LAS float*)(L + HL_SSQ))[ww * 32 + 16 + c16]; } \
              const float r0 = rsqrtf(t0 * (1.f / 128.f) + NORM_EPS), r1 = rsqrtf(t1 * (1.f / 128.f) + NORM_EPS); \
              const size_t off0 = ((prow0) + c16) * 512 + hh * 128 + 16 * w + 4 * g, off1 = off0 + 16 * 512; \
              const float ha[4] = {bflo(pg0.x), bfhi(pg0.x), bflo(pg0.y), bfhi(pg0.y)}, hb[4] = {bflo(pg1.x), bfhi(pg1.x), bflo(pg1.y), bfhi(pg1.y)}; \
              float ya[4], yb[4]; \
              _Pragma("unroll") for (int r = 0; r < 4; ++r) { ya[r] = po0[r] * r0 * gn[r] * ha[r] * fsig(ha[r]); yb[r] = po1[r] * r1 * gn[r] * hb[r] * fsig(hb[r]); } \
              u32x2 wa, wb; wa.x = cvtpk(ya[0], ya[1]); wa.y = cvtpk(ya[2], ya[3]); wb.x = cvtpk(yb[0], yb[1]); wb.y = cvtpk(yb[2], yb[3]); \
              *(u32x2*)(YH + off0) = wa; *(u32x2*)(YH + off1) = wb; } while (0)
#define HG_STEP(S, cc) do { const size_t row0 = T0 + 32 * (size_t)(cc); \
            float cs0[4], cs1[4], kk0[4], kk1[4], qv0[4], qv1[4]; \
            { float s0 = 0.f, s1 = 0.f; \
              _Pragma("unroll") for (int i = 0; i < 4; ++i) { const float f0 = lb0 + (1.f - lb0) * fsig(bflo(S.rf[i])), f1 = lb1 + (1.f - lb1) * fsig(bfhi(S.rf[i])); \
                  s0 += __builtin_amdgcn_logf(f0) * 0.69314718056f; s1 += __builtin_amdgcn_logf(f1) * 0.69314718056f; cs0[i] = s0; cs1[i] = s1; kk0[i] = 1.f - f0; kk1[i] = 1.f - f1; qv0[i] = bflo(S.rq[i]); qv1[i] = bfhi(S.rq[i]); } \
              *(LAS f32x2_t*)(L + HL_GSUM + (tq * 128 + 2 * cp) * 4) = (f32x2_t){s0, s1}; } \
            __syncthreads();                                                                      \
            if ((cc) > 0) HG_FIN(row0 - 32); \
            { float gA[8], gB[8]; \
              _Pragma("unroll") for (int t_ = 0; t_ < 8; ++t_) { const f32x2_t gg = *(const LAS f32x2_t*)(L + HL_GSUM + (t_ * 128 + 2 * cp) * 4); gA[t_] = gg[0]; gB[t_] = gg[1]; } \
              float preA = 0.f, preB = 0.f; \
              _Pragma("unroll") for (int t_ = 0; t_ < 8; ++t_) if (t_ < tq) { preA += gA[t_]; preB += gB[t_]; } \
              const float g01A = (gA[0] + gA[1]) + (gA[2] + gA[3]), g01B = (gB[0] + gB[1]) + (gB[2] + gB[3]); \
              const float hiA = (gA[4] + gA[5]) + (gA[6] + gA[7]), hiB = (gB[4] + gB[5]) + (gB[6] + gB[7]); \
              const float glA = g01A + hiA, glB = g01B + hiB, c01A = __expf(-hiA), c01B = __expf(-hiB); \
              _Pragma("unroll") for (int i = 0; i < 4; ++i) { const float GA_ = preA + cs0[i], GB_ = preB + cs1[i]; const int t = 4 * tq + i; \
                  const float k2a = kk0[i] * __expf(glA - GA_), k2b = kk1[i] * __expf(glB - GB_); \
                  *(LAS unsigned*)(L + HL_QP + t * HS_Q + cp * 4) = cvtpk(qv0[i] * __expf(GA_ - g01A), qv1[i] * __expf(GB_ - g01B)); \
                  *(LAS unsigned*)(L + HL_KP + t * HS_Q + cp * 4) = cvtpk(k2a * c01A, k2b * c01B); \
                  *(LAS unsigned*)(L + HL_KPP + t * HS_V + cp * 4) = cvtpk(k2a, k2b); } \
              if (tq == 0) { *(LAS f32x2_t*)(L + HL_EREF + cp * 8) = (f32x2_t){__expf(g01A), __expf(g01B)}; *(LAS f32x2_t*)(L + HL_DEC + cp * 8) = (f32x2_t){__expf(glA), __expf(glB)}; } \
              *(LAS v4u*)(L + HL_VV + tv * HS_V + cv * 16) = S.rv; } \
            __syncthreads();                                                                      \
            pg8::f32x4 d00 = {0.f, 0.f, 0.f, 0.f}, d01 = d00, d11 = d00; \
            _Pragma("unroll") for (int k4 = 0; k4 < 4; ++k4) { \
                const bf16x8 ka0 = *(const LAS bf16x8*)(L + HL_KP + c16 * HS_Q + (32 * k4 + 8 * g) * 2), ka1 = *(const LAS bf16x8*)(L + HL_KP + (16 + c16) * HS_Q + (32 * k4 + 8 * g) * 2); \
                const bf16x8 qb0 = *(const LAS bf16x8*)(L + HL_QP + c16 * HS_Q + (32 * k4 + 8 * g) * 2), qb1 = *(const LAS bf16x8*)(L + HL_QP + (16 + c16) * HS_Q + (32 * k4 + 8 * g) * 2); \
                d00 = mfma16(ka0, qb0, d00); d01 = mfma16(ka0, qb1, d01); d11 = mfma16(ka1, qb1, d11); } \
            _Pragma("unroll") for (int r = 0; r < 4; ++r) if (4 * g + r > c16) { d00[r] = 0.f; d11[r] = 0.f; } \
            bf16x8 am0, am1; \
            { v4u t0; t0.x = cvtpk(d00[0], d00[1]); t0.y = cvtpk(d00[2], d00[3]); t0.z = 0u; t0.w = 0u; am0 = __builtin_bit_cast(bf16x8, t0); \
              v4u t1; t1.x = cvtpk(d01[0], d01[1]); t1.y = cvtpk(d01[2], d01[3]); t1.z = cvtpk(d11[0], d11[1]); t1.w = cvtpk(d11[2], d11[3]); am1 = __builtin_bit_cast(bf16x8, t1); } \
            bf16x8 vfr; \
            { const s16x4 x0 = ldtr(L + HL_VV + (4 * g + qd) * HS_V + (16 * w + 4 * pd) * 2), x1 = ldtr(L + HL_VV + (16 + 4 * g + qd) * HS_V + (16 * w + 4 * pd) * 2); \
              vfr = (bf16x8){x0[0], x0[1], x0[2], x0[3], x1[0], x1[1], x1[2], x1[3]}; } \
            pg8::f32x4 o0 = {0.f, 0.f, 0.f, 0.f}, o1 = o0; \
            _Pragma("unroll") for (int k4 = 0; k4 < 4; ++k4) { \
                const pg8::f32x4 e0 = *(const LAS pg8::f32x4*)(L + HL_EREF + (32 * k4 + 4 * g) * 4), e1 = *(const LAS pg8::f32x4*)(L + HL_EREF + (32 * k4 + 16 + 4 * g) * 4); \
                const pg8::f32x4 s0 = st[2 * k4] * e0, s1 = st[2 * k4 + 1] * e1; \
                v4u sw; sw.x = cvtpk(s0[0], s0[1]); sw.y = cvtpk(s0[2], s0[3]); sw.z = cvtpk(s1[0], s1[1]); sw.w = cvtpk(s1[2], s1[3]); \
                const bf16x8 sa = __builtin_bit_cast(bf16x8, sw); \
                const u32x2 qa0 = *(const LAS u32x2*)(L + HL_QP + c16 * HS_Q + (32 * k4 + 4 * g) * 2), qa1 = *(const LAS u32x2*)(L + HL_QP + c16 * HS_Q + (32 * k4 + 16 + 4 * g) * 2); \
                const u32x2 qc0 = *(const LAS u32x2*)(L + HL_QP + (16 + c16) * HS_Q + (32 * k4 + 4 * g) * 2), qc1 = *(const LAS u32x2*)(L + HL_QP + (16 + c16) * HS_Q + (32 * k4 + 16 + 4 * g) * 2); \
                const v4u qw0 = {qa0.x, qa0.y, qa1.x, qa1.y}, qw1 = {qc0.x, qc0.y, qc1.x, qc1.y}; \
                o0 = mfma16(sa, __builtin_bit_cast(bf16x8, qw0), o0); o1 = mfma16(sa, __builtin_bit_cast(bf16x8, qw1), o1); } \
            o0 = mfma16(vfr, am0, o0); o1 = mfma16(vfr, am1, o1); \
            _Pragma("unroll") for (int i = 0; i < 8; ++i) { \
                const s16x4 x0 = ldtr(L + HL_KPP + (4 * g + qd) * HS_V + (16 * i + 4 * pd) * 2), x1 = ldtr(L + HL_KPP + (16 + 4 * g + qd) * HS_V + (16 * i + 4 * pd) * 2); \
                const bf16x8 kfr = {x0[0], x0[1], x0[2], x0[3], x1[0], x1[1], x1[2], x1[3]}; \
                const pg8::f32x4 dc = *(const LAS pg8::f32x4*)(L + HL_DEC + (16 * i + 4 * g) * 4); \
                st[i] = mfma16(kfr, vfr, st[i] * dc); } \
            { float s0 = o0[0] * o0[0] + o0[1] * o0[1] + o0[2] * o0[2] + o0[3] * o0[3], s1 = o1[0] * o1[0] + o1[1] * o1[1] + o1[2] * o1[2] + o1[3] * o1[3]; \
              s0 += __shfl_xor(s0, 16); s0 += __shfl_xor(s0, 32); s1 += __shfl_xor(s1, 16); s1 += __shfl_xor(s1, 32); \
              if (g == 0) { ((LAS float*)(L + HL_SSQ))[w * 32 + c16] = s0; ((LAS float*)(L + HL_SSQ))[w * 32 + 16 + c16] = s1; } } \
            po0 = o0; po1 = o1; pg0 = S.h0; pg1 = S.h1; } while (0)
        HgStage sA, sB; pg8::f32x4 po0 = {0.f, 0.f, 0.f, 0.f}, po1 = po0; u32x2 pg0 = {0u, 0u}, pg1 = pg0;
        HG_LOAD(sA, 0); HG_LOAD(sB, 1);
        for (int c = 0; c < SEQ / 32; c += 2) {
            HG_STEP(sA, c);
            if (c + 2 < SEQ / 32) HG_LOAD(sA, c + 2);
            HG_STEP(sB, c + 1);
            if (c + 3 < SEQ / 32) HG_LOAD(sB, c + 3);
        }
        __syncthreads();
        HG_FIN(T0 + SEQ - 32);
#undef HG_LOAD
#undef HG_FIN
#undef HG_STEP
        __syncthreads();
    }
}

__device__ __forceinline__ void attn_naive(Frame& F, const Args& A, int wg0, int nwg) {
    bf16* Q = (bf16*)(F.ws + WS_Q); const bf16* KV = (const bf16*)(F.ws + WS_KV);
    const float* sinks = A.in[4];
    const int gt = (blockIdx.x - wg0) * (NWAVES * 64) + F.tid, NGT = nwg * NWAVES * 64;
    for (int idx = gt; idx < NTOK * 8; idx += NGT) {
        const int h = idx & 7, tok = idx >> 3, t = tok & (SEQ - 1), kvh = h >> 2;
        float q[64], o[64];
        { const v4u* qp = (const v4u*)(Q + (size_t)tok * 512 + h * 64);
#pragma unroll
          for (int c = 0; c < 8; ++c) { const v4u w = qp[c];
#pragma unroll
              for (int i = 0; i < 4; ++i) { q[8 * c + 2 * i] = bflo(w[i]); q[8 * c + 2 * i + 1] = bfhi(w[i]); } } }
#pragma unroll
        for (int d = 0; d < 64; ++d) o[d] = 0.f;
        float m = sinks[h] * LOG2E, l = 1.f;
        const int j0 = (t >= 127) ? t - 127 : 0;
        for (int j = j0; j <= t; ++j) {
            const size_t krow = (size_t)(tok - t + j) * 256;
            const v4u* kp = (const v4u*)(KV + krow + kvh * 64);
            float s = 0.f;
#pragma unroll
            for (int c = 0; c < 8; ++c) { const v4u w = kp[c];
#pragma unroll
                for (int i = 0; i < 4; ++i) { s += q[8 * c + 2 * i] * bflo(w[i]); s += q[8 * c + 2 * i + 1] * bfhi(w[i]); } }
            const float mn = fmaxf(m, s), al = exp2f(m - mn), p = exp2f(s - mn);
            l = l * al + p; m = mn;
            const v4u* vp = (const v4u*)(KV + krow + 128 + kvh * 64);
#pragma unroll
            for (int c = 0; c < 8; ++c) { const v4u w = vp[c];
#pragma unroll
                for (int i = 0; i < 4; ++i) { o[8 * c + 2 * i] = o[8 * c + 2 * i] * al + p * bflo(w[i]); o[8 * c + 2 * i + 1] = o[8 * c + 2 * i + 1] * al + p * bfhi(w[i]); } }
        }
        const float il = 1.f / l;
        v4u* op = (v4u*)((bf16*)(F.ws + WS_AO) + (size_t)tok * 512 + h * 64);
#pragma unroll
        for (int c = 0; c < 8; ++c) { v4u w;
#pragma unroll
            for (int i = 0; i < 4; ++i) w[i] = pk2(o[8 * c + 2 * i] * il, o[8 * c + 2 * i + 1] * il);
            op[c] = w; }
    }
}

__device__ __forceinline__ void hgrn_naive(Frame& F, const Args& A, int wg0, int nwg) {
    bf16* HQ = (bf16*)(F.ws + WS_HQ); const bf16* HFp = (const bf16*)(F.ws + WS_HF); const bf16* HI = (const bf16*)(F.ws + WS_HI); const bf16* HG = (const bf16*)(F.ws + WS_HG);
    const int gi = F.tid >> 7, n = F.tid & 127;
    LAS float* lf = (LAS float*)(F.lds) + gi * 512;
    LAS float* lq = lf + 128; LAS float* red = lf + 256;
    for (int unit = (blockIdx.x - wg0) * 4 + gi; unit < 128 + 3; unit += nwg * 4) {
        const bool act = unit < 128;
        if ((unit - gi) >= 128) break;
        const int b = act ? unit >> 2 : 0, hh = act ? unit & 3 : 0;
        const int ch = hh * 128 + n;
        const float a0 = A.in[5][ch], a1 = A.in[5][512 + ch];
        const float lb = 1.f / (1.f + __expf(a1 - a0));
        const float gn = A.in[6][ch];
        float S[128];
#pragma unroll
        for (int k = 0; k < 128; ++k) S[k] = 0.f;
        for (int t = 0; t < SEQ; ++t) {
            const size_t off = (size_t)(b * SEQ + t) * 512 + ch;
            const float f = lb + (1.f - lb) * sigmoidf_(bf2f(HFp[off]));
            lf[n] = f; lq[n] = bf2f(HQ[off]);
            const float v = bf2f(HI[off]);
            __syncthreads();
            float o = 0.f;
#pragma unroll
            for (int k = 0; k < 128; ++k) { const float fk = lf[k]; S[k] = fk * S[k] + (1.f - fk) * v; o += lq[k] * S[k]; }
            const float ss = wave_sum(o * o);
            if (F.lane == 0) red[(n >> 6)] = ss;
            __syncthreads();
            const float tot = red[0] + red[1];
            const float y = o * rsqrtf(tot * (1.f / 128.f) + NORM_EPS) * gn;
            const float hg = bf2f(HG[off]);
            if (act) ((bf16*)(F.ws + WS_YH))[off] = (bf16)f2bf(y * hg * sigmoidf_(hg));
        }
    }
}

__device__ __forceinline__ float wave_max(float v) {
#pragma unroll
    for (int o = 1; o < 64; o <<= 1) v = fmaxf(v, __shfl_xor(v, o));
    return v;
}
__device__ __forceinline__ void m0_router(Frame& F, const Args& A) {
    unsigned char* ws = F.ws;
    const float* xin = A.in[0]; const bf16* MX = (const bf16*)(ws + WS_MX); bf16* HB = (bf16*)(ws + WS_MX); unsigned char* U2F = ws + WS_U; const float* gffn = A.in[10];
    int* TOPE = (int*)(ws + WS_TOPE); float* GATE = (float*)(ws + WS_GATE); int* LRANK = (int*)(ws + WS_LRANK); int* CNT = (int*)(ws + WS_CNT);
    LAS float* WL = (LAS float*)(F.lds);
    LAS int* hist = (LAS int*)(F.lds + RING_BYTES);
    const int lane = F.lane;
    __syncthreads();
    for (int idx = F.tid; idx < 1024 * 32; idx += NWAVES * 64) { const int k = idx >> 5, e = idx & 31; const int l = (k & 255) >> 2, j = k >> 8, i = k & 3;
        WL[((((j * 4 + i) * 8 + (e >> 2)) * 64 + l) << 2) + (e & 3)] = gffn[k] * A.in[11][idx]; }
    f32x4 gv[4];
#pragma unroll
    for (int j = 0; j < 4; ++j) gv[j] = *(const f32x4*)(gffn + 256 * j + 4 * lane);
    const float brt = A.in[12][lane >> 1];
    __syncthreads();
    for (int seg = blockIdx.x; seg < NTOK / 256; seg += F.G) {
        if (F.tid < 32) hist[F.tid] = 0;
        __syncthreads();
        for (int it = 0; it < 16; ++it) {
            const int tok0 = seg * 256 + F.wave * 32 + 2 * it;
            f32x4 h[2][4]; float ssq[2];
#pragma unroll
            for (int r = 0; r < 2; ++r) { float s = 0.f;
#pragma unroll
                for (int j = 0; j < 4; ++j) { const size_t off = (size_t)(tok0 + r) * DM + 256 * j + 4 * lane;
                    const f32x4 xv = __builtin_nontemporal_load((const f32x4*)(xin + off)); const u32x2 mw = __builtin_nontemporal_load((const u32x2*)(MX + off));
                    h[r][j] = (f32x4){xv.x + bflo(mw.x), xv.y + bfhi(mw.x), xv.z + bflo(mw.y), xv.w + bfhi(mw.y)};
                    s += (h[r][j].x * h[r][j].x + h[r][j].y * h[r][j].y) + (h[r][j].z * h[r][j].z + h[r][j].w * h[r][j].w);
                    { u32x2 hw; hw.x = pk2(h[r][j].x, h[r][j].y); hw.y = pk2(h[r][j].z, h[r][j].w); *(u32x2*)(HB + off) = hw; } }
                ssq[r] = wave_sum(s); }
            const float rs0 = rsqrtf(ssq[0] * (1.f / DM) + NORM_EPS), rs1 = rsqrtf(ssq[1] * (1.f / DM) + NORM_EPS);
#pragma unroll
            for (int j = 0; j < 4; ++j) { const f32x4 t0 = h[0][j] * gv[j] * rs0, t1 = h[1][j] * gv[j] * rs1;
                *(unsigned*)(U2F + (size_t)tok0 * 1024 + 256 * j + 4 * lane) = pk4_fp8(clamp448(t0.x), clamp448(t0.y), clamp448(t0.z), clamp448(t0.w));
                *(unsigned*)(U2F + (size_t)(tok0 + 1) * 1024 + 256 * j + 4 * lane) = pk4_fp8(clamp448(t1.x), clamp448(t1.y), clamp448(t1.z), clamp448(t1.w)); }
            float acc[2][32];
#pragma unroll
            for (int e = 0; e < 32; ++e) { acc[0][e] = 0.f; acc[1][e] = 0.f; }
#pragma unroll 1
            for (int j = 0; j < 4; ++j) {
                const LAS float* wj = WL + ((j * 32 * 64 + lane) << 2);
#pragma unroll
                for (int i = 0; i < 4; ++i) { const float h0 = h[0][0][i], h1 = h[1][0][i];
#pragma unroll
                    for (int eg = 0; eg < 8; ++eg) { const f32x4 wv = *(const LAS f32x4*)(wj + (((i * 8 + eg) * 64) << 2));
#pragma unroll
                        for (int c = 0; c < 4; ++c) { acc[0][4 * eg + c] += h0 * wv[c]; acc[1][4 * eg + c] += h1 * wv[c]; } } }
                h[0][0] = h[0][1]; h[0][1] = h[0][2]; h[0][2] = h[0][3]; h[1][0] = h[1][1]; h[1][1] = h[1][2]; h[1][2] = h[1][3];
            }
#pragma unroll
            for (int r = 0; r < 2; ++r) {
                float v16[16], v8[8], v4[4], v2[2], v1;
#pragma unroll
                for (int i = 0; i < 16; ++i) { const float a = acc[r][i], bb = acc[r][i + 16]; const bool up = (lane & 32) != 0; const float keep = up ? bb : a, send = up ? a : bb; v16[i] = keep + __shfl_xor(send, 32); }
#pragma unroll
                for (int i = 0; i < 8; ++i) { const float a = v16[i], bb = v16[i + 8]; const bool up = (lane & 16) != 0; const float keep = up ? bb : a, send = up ? a : bb; v8[i] = keep + __shfl_xor(send, 16); }
#pragma unroll
                for (int i = 0; i < 4; ++i) { const float a = v8[i], bb = v8[i + 4]; const bool up = (lane & 8) != 0; const float keep = up ? bb : a, send = up ? a : bb; v4[i] = keep + __shfl_xor(send, 8); }
#pragma unroll
                for (int i = 0; i < 2; ++i) { const float a = v4[i], bb = v4[i + 2]; const bool up = (lane & 4) != 0; const float keep = up ? bb : a, send = up ? a : bb; v2[i] = keep + __shfl_xor(send, 4); }
                { const float a = v2[0], bb = v2[1]; const bool up = (lane & 2) != 0; const float keep = up ? bb : a, send = up ? a : bb; v1 = keep + __shfl_xor(send, 2); }
                v1 += __shfl_xor(v1, 1);
                float lg = v1 * (r ? rs1 : rs0) + brt;
                float tv[4]; int te[4];
#pragma unroll
                for (int k = 0; k < 4; ++k) { const float mxv = wave_max(lg); const unsigned long long bal = __ballot(lg == mxv); const int ln = __ffsll((long long)bal) - 1;
                    tv[k] = mxv; te[k] = ln >> 1; if ((lane >> 1) == te[k]) lg = -INFINITY; }
                const int tok = tok0 + r;
                const float e1 = __expf(tv[1] - tv[0]), e2 = __expf(tv[2] - tv[0]), e3 = __expf(tv[3] - tv[0]), inv = 1.f / (1.f + e1 + e2 + e3);
                if (lane == 0) {
                    const int l0 = atomicAdd((int*)&hist[te[0]], 1), l1 = atomicAdd((int*)&hist[te[1]], 1), l2 = atomicAdd((int*)&hist[te[2]], 1), l3 = atomicAdd((int*)&hist[te[3]], 1);
                    *(int4*)(TOPE + tok * 4) = make_int4(te[0], te[1], te[2], te[3]);
                    *(float4*)(GATE + tok * 4) = make_float4(inv, e1 * inv, e2 * inv, e3 * inv);
                    *(int4*)(LRANK + tok * 4) = make_int4(l0, l1, l2, l3);
                }
            }
        }
        __syncthreads();
        if (F.tid < 32) CNT[seg * 32 + F.tid] = hist[F.tid];
        __syncthreads();
    }
}

__device__ __forceinline__ void m1_dispatch(Frame& F, int p) {
    unsigned char* ws = F.ws;
    const int* TOPE = (const int*)(ws + WS_TOPE); const float* GATE = (const float*)(ws + WS_GATE); const int* LRANK = (const int*)(ws + WS_LRANK);
    const int* CNT = (const int*)(ws + WS_CNT); int* EST = (int*)(ws + WS_EST); int* ROWOF = (int*)(ws + WS_ROWOF);
    float* GATEROW = (float*)(ws + WS_GATEROW);
    const unsigned char* U2F = ws + WS_U; unsigned char* XS = ws + WS_XS;
    LAS int* cum = (LAS int*)(F.lds); LAS int* part = cum + 8192; LAS int* tot = part + 512; LAS int* tst = tot + 32;
    __syncthreads();
    for (int i = F.tid; i < 8192; i += NWAVES * 64) cum[i] = CNT[i];
    __syncthreads();
    { const int e = F.tid & 31, pt = F.tid >> 5; int s = 0;
      for (int j = 0; j < 16; ++j) { const int idx = (16 * pt + j) * 32 + e; const int t = cum[idx]; cum[idx] = s; s += t; }
      part[pt * 32 + e] = s; }
    __syncthreads();
    { const int e = F.tid & 31, pt = F.tid >> 5; int off = 0;
      for (int q = 0; q < pt; ++q) off += part[q * 32 + e];
      for (int j = 0; j < 16; ++j) cum[(16 * pt + j) * 32 + e] += off;
      if (pt == 15) tot[e] = off + part[15 * 32 + e]; }
    __syncthreads();
    if (F.tid == 0) { int a = 0; for (int e = 0; e < 32; ++e) { tst[e] = a; a += (tot[e] + 255) >> 8; } tst[32] = a; }
    __syncthreads();
    if (blockIdx.x == 0 && F.tid < 64) EST[p * 64 + F.tid] = (F.tid <= 32) ? tst[F.tid] : 0;
    for (int e = blockIdx.x; e < 32; e += F.G) {
        const int r0 = 256 * tst[e] + tot[e], r1 = 256 * tst[e + 1];
        for (int r = r0 + F.tid; r < r1; r += NWAVES * 64) GATEROW[r] = 0.f;
    }
    const int gw = blockIdx.x * NWAVES + F.wave, NGW = F.G * NWAVES;
    for (int tok0 = 4 * gw; tok0 < NTOK; tok0 += 4 * NGW) {
        int row = 0;
        if (F.lane < 16) {
            const int ai = tok0 * 4 + F.lane, tok = tok0 + (F.lane >> 2);
            const int e = TOPE[ai];
            row = 256 * tst[e] + cum[(tok >> 8) * 32 + e] + LRANK[ai];
            ROWOF[ai] = row; GATEROW[row] = GATE[ai];
        }
        v4u o[4];
#pragma unroll
        for (int i = 0; i < 4; ++i) o[i] = *(const v4u*)(U2F + (size_t)(tok0 + i) * 1024 + F.lane * 16);
#pragma unroll
        for (int i = 0; i < 4; ++i)
#pragma unroll
            for (int k = 0; k < 4; ++k) { const int rk = __builtin_amdgcn_readlane(row, 4 * i + k); *(v4u*)(XS + (size_t)rk * 1024 + F.lane * 16) = o[i]; }
    }
}

__device__ __forceinline__ void m4_combine(Frame& F, const Args& A, int p) {
    unsigned char* ws = F.ws;
    const int* ROWOF = (const int*)(ws + WS_ROWOF); const unsigned char* Y = ws + WS_Y; const float* gf = A.in[17]; const float* xin = A.in[0]; const bf16* MX = (const bf16*)(ws + WS_MX);
    const int gw = blockIdx.x * NWAVES + F.wave, NGW = F.G * NWAVES;
    f32x4 gv[4];
#pragma unroll
    for (int j = 0; j < 4; ++j) gv[j] = *(const f32x4*)(gf + 256 * j + 4 * F.lane);
    for (int tok = p * HALF_TOK + gw; tok < (p + 1) * HALF_TOK; tok += NGW) {
        const int rv = ROWOF[tok * 4 + (F.lane & 3)];
        int rk[4];
#pragma unroll
        for (int k = 0; k < 4; ++k) rk[k] = __builtin_amdgcn_readlane(rv, k);
        float* hp = F.out + (size_t)tok * DM + 4 * F.lane;
        f32x4 v[4]; float s = 0.f;
#pragma unroll
        for (int j = 0; j < 4; ++j) {
            { const u32x2 mw = __builtin_nontemporal_load((const u32x2*)(MX + (size_t)tok * DM + 4 * F.lane + 256 * j)); v[j] = (f32x4){bflo(mw.x), bfhi(mw.x), bflo(mw.y), bfhi(mw.y)}; }
#pragma unroll
            for (int k = 0; k < 4; ++k) { const unsigned w = __builtin_nontemporal_load((const unsigned*)(Y + (size_t)rk[k] * 1024 + 256 * j + 4 * F.lane));
                const f32x2_t lo = __builtin_amdgcn_cvt_pk_f32_fp8((int)w, false), hi2 = __builtin_amdgcn_cvt_pk_f32_fp8((int)w, true);
                v[j].x += lo[0] * 0.0625f; v[j].y += lo[1] * 0.0625f; v[j].z += hi2[0] * 0.0625f; v[j].w += hi2[1] * 0.0625f; }
            s += (v[j].x * v[j].x + v[j].y * v[j].y) + (v[j].z * v[j].z + v[j].w * v[j].w);
        }
        const float rs = rsqrtf(wave_sum(s) * (1.f / DM) + NORM_EPS);
#pragma unroll
        for (int j = 0; j < 4; ++j) __builtin_nontemporal_store(v[j] * rs * gv[j], (f32x4*)(hp + 256 * j));
    }
}

constexpr int NPH = 11;
template <unsigned MASK> __global__ void __launch_bounds__(NWAVES * 64, 2) mega_fwd(Args args) {
    extern __shared__ __attribute__((aligned(16))) unsigned char lds[];
    Frame F;
    F.lds = (LAS unsigned char*)lds;
    F.tid = threadIdx.x; F.lane = F.tid & 63; F.wave = __builtin_amdgcn_readfirstlane(F.tid >> 6); F.G = gridDim.x;
    F.out = args.out; F.ws = args.ws;
    unsigned char* ws = args.ws;
    volatile LAS unsigned* MISC = (volatile LAS unsigned*)(F.lds + MISC_OFF);
    for (int u = F.tid; u < (LDS_BYTES - RING_BYTES) / 4; u += NWAVES * 64) ((LAS unsigned*)(F.lds + RING_BYTES))[u] = 0u;
    __syncthreads();
    const int lo = args.ph_lo, hi = args.ph_hi;
    XcdBarrier bar; bar.bar = (unsigned*)(ws + WS_CTL) + CW_BAR; bar.x = 0; bar.st = nullptr;
    if (hi - lo > 1) bar = xcd_barrier_post((unsigned*)(ws + WS_CTL) + CW_BAR, MISC + 8);
#ifndef DUP_ATTN
#define DUP_ATTN 1
#endif
#ifndef DUP_HGRN
#define DUP_HGRN 1
#endif
#ifndef DUP_MASK
#define DUP_MASK 0u
#endif
#define REPS(k) (((DUP_MASK >> (k)) & 1u) ? 2 : 1)
#define HAS(k) ((MASK >> (k)) & 1u)
#define IN(k) (lo <= (k) && (k) < hi)
#define SEAM(k) do { if (IN(k) && IN((k) + 1)) xcd_barrier(bar); } while (0)

    if (HAS(0) && IN(0)) { for (int rep = 0; rep < REPS(0); ++rep) { p0_prologue(F, args); moe_weight_prep(F, args, 0, F.G, 0, WP_SPLIT); } } SEAM(0);

    if (HAS(1) && IN(1)) {
        {
            pg8::Gemm g{(const pg8::bf16_t*)(ws + WS_U), (const pg8::bf16_t*)(ws + WS_WIN), NTOK, IN_BF, 1024, nullptr, nullptr, 0x7a7a7a7a, 0x7f7f7f7f};
            pg8::StaticOrder S; S.init(NTOK, IN_BF, F.G, (int)blockIdx.x);
            EpiInProj E{ws, args.in[3], (const float*)(ws + WS_ROPE), 0, 3};
            pg8::gemm_phase<EpiInProj, pg8::StaticOrder, true, true>(F.lds, g, S, E);
        }
        {
            pg8::Gemm g{(const pg8::bf16_t*)(ws + WS_U8), (const pg8::bf16_t*)(ws + WS_WIN8), NTOK, INC - IN_BF, 512, nullptr, nullptr, 0x7a7a7a7a, 0x7f7f7f7f};
            pg8::StaticOrder S; S.init(NTOK, INC - IN_BF, F.G, (int)blockIdx.x);
            EpiInProj E{ws, args.in[3], (const float*)(ws + WS_ROPE), 3, 8};
            pg8::gemm_phase<EpiInProj, pg8::StaticOrder, true, true, true>(F.lds, g, S, E);
        }
    } SEAM(1);

    if (HAS(2) && IN(2)) for (int rep = 0; rep < REPS(2); ++rep) {
        const int half = F.G / 2;
        #if defined(NAIVE_ATTN)
        if ((int)blockIdx.x >= half) attn_naive(F, args, half, F.G - half);
#else
        if ((int)blockIdx.x >= half) { for (int r2 = 0; r2 < DUP_ATTN; ++r2) { attn_phase(F, args, half, F.G - half); moe_weight_prep(F, args, half, F.G - half, WP_SPLIT, WP_NIT); } }
#endif
#if defined(NAIVE_HGRN)
        if ((int)blockIdx.x < half) hgrn_naive(F, args, 0, half);
#else
        if ((int)blockIdx.x < half) for (int r2 = 0; r2 < DUP_HGRN; ++r2) hgrn_phase(F, args, 0, half);
#endif
    } SEAM(2);

    if (HAS(3) && IN(3)) {
        pg8::Gemm g{(const pg8::bf16_t*)(ws + WS_AO), (const pg8::bf16_t*)(ws + WS_WUA), NTOK, 1024, 512, (const pg8::bf16_t*)(ws + WS_YH), (const pg8::bf16_t*)(ws + WS_WUH), 0x7a7a7a7a, 0x7f7f7f7f};
        pg8::StaticOrder S; S.init(NTOK, 1024, F.G, (int)blockIdx.x);
        EpiFuse E{(const bf16*)(ws + WS_GA), (bf16*)(ws + WS_GB), ws + WS_HQ};
        pg8::gemm_phase<EpiFuse, pg8::StaticOrder, true, true, false, true>(F.lds, g, S, E);
    } SEAM(3);
    if (HAS(5) && IN(5)) for (int rep = 0; rep < REPS(5); ++rep) {
        pg8::Gemm g{(const pg8::bf16_t*)(ws + WS_HQ), (const pg8::bf16_t*)(ws + WS_WOUT), NTOK, 1024, 512, nullptr, nullptr, 0x7a7a7a7a, 0x7c7c7c7c};
        pg8::StaticOrder S; S.init(NTOK, 1024, F.G, (int)blockIdx.x);
        EpiPlain E{(bf16*)(ws + WS_MX)};
        pg8::gemm_phase<EpiPlain, pg8::StaticOrder, true, true, true>(F.lds, g, S, E);
    } SEAM(5);

    if (HAS(6) && IN(6)) { for (int rep = 0; rep < REPS(6); ++rep) m0_router(F, args); } SEAM(6);

    {
        const int p = 0;
        asm volatile("" : "+s"(ws), "+v"(F.tid), "+v"(F.lane)); F.ws = ws; { float* o_ = F.out; asm volatile("" : "+s"(o_)); F.out = o_; }
        if (HAS(7) && IN(7)) { for (int rep = 0; rep < REPS(7); ++rep) m1_dispatch(F, p); } SEAM(7);
        if (HAS(8) && IN(8)) {
            pg8::Gemm g{(const pg8::bf16_t*)(ws + WS_XS), (const pg8::bf16_t*)(ws + WS_W1), HALF_ROWS, 2048, 512, nullptr, nullptr, 0x7a7a7a7a, 0x7f7f7f7f};
            MoeOrder S; S.init((const int*)(ws + WS_EST), F.lane, 3, F.G, (int)blockIdx.x);
            EpiSwiGlu E{ws + WS_ACT, args.in[14]};
            pg8::gemm_phase<EpiSwiGlu, MoeOrder, true, true, true>(F.lds, g, S, E);
        } SEAM(8);
        if (HAS(9) && IN(9)) {
            pg8::Gemm g{(const pg8::bf16_t*)(ws + WS_ACT), (const pg8::bf16_t*)(ws + WS_W2), HALF_ROWS, 1024, 512, nullptr, nullptr, 0x7a7a7a7a, 0x7f7f7f7f};
            MoeOrder S; S.init((const int*)(ws + WS_EST), F.lane, 2, F.G, (int)blockIdx.x);
            EpiMoeOut E{ws + WS_Y, args.in[16], (const float*)(ws + WS_GATEROW)};
            pg8::gemm_phase<EpiMoeOut, MoeOrder, true, true, true>(F.lds, g, S, E);
        } SEAM(9);
        if (HAS(10) && IN(10)) { m4_combine(F, args, p); }
    }
#undef IN
#undef SEAM
}

#ifndef MK_SPLIT
#define MK_SPLIT 0
#endif
constexpr unsigned MASK_ALL = (1u << NPH) - 1u;
typedef void (*kern_t)(Args);
template <int K> struct PhaseTab { static void fill(kern_t* t) { t[K] = mega_fwd<(1u << K)>; PhaseTab<K - 1>::fill(t); } };
template <> struct PhaseTab<-1> { static void fill(kern_t*) {} };
extern "C" void kernel_launch(void* const* d_in, const int* in_sizes, int n_in, void* d_out, int out_size, void* d_ws, size_t ws_size, hipStream_t stream) {
    static int grid = 0;
    static kern_t tab[NPH + 1];
    if (grid == 0) {
        if (n_in != 18 || out_size != NTOK * DM || ws_size < WS_END) { fprintf(stderr, "kernel_launch: unexpected shapes (n_in %d out %d ws %zu)\n", n_in, out_size, ws_size); grid = -1; return; }
        int dev = 0, cus = 0, per_cu = 0;
        if (hipGetDevice(&dev) != hipSuccess || hipDeviceGetAttribute(&cus, hipDeviceAttributeMultiprocessorCount, dev) != hipSuccess) { grid = -1; return; }
#if MK_SPLIT
        PhaseTab<NPH - 1>::fill(tab);
        for (int k = 0; k < NPH; ++k)
            if (hipFuncSetAttribute((const void*)tab[k], hipFuncAttributeMaxDynamicSharedMemorySize, LDS_BYTES) != hipSuccess) { fprintf(stderr, "kernel_launch: hipFuncSetAttribute failed\n"); grid = -1; return; }
#else
        tab[NPH] = mega_fwd<MASK_ALL>;
        if (hipFuncSetAttribute((const void*)tab[NPH], hipFuncAttributeMaxDynamicSharedMemorySize, LDS_BYTES) != hipSuccess) { fprintf(stderr, "kernel_launch: hipFuncSetAttribute failed\n"); grid = -1; return; }
        if (hipOccupancyMaxActiveBlocksPerMultiprocessor(&per_cu, (const void*)tab[NPH], NWAVES * 64, LDS_BYTES) != hipSuccess || per_cu < 1) { fprintf(stderr, "kernel_launch: occupancy query says %d\n", per_cu); }
#endif
        (void)hipGetLastError();
        grid = cus;
        if (grid > 256) grid = 256;
    }
    if (grid < 0) return;
    (void)hipMemsetAsync((char*)d_ws + WS_CTL, 0, CTL_ZERO_BYTES, stream);
    Args a{};
    for (int i = 0; i < 18; ++i) a.in[i] = (const float*)d_in[i];
    a.out = (float*)d_out; a.ws = (unsigned char*)d_ws;
#if MK_SPLIT
    for (int k = 0; k < NPH; ++k) { a.ph_lo = k; a.ph_hi = k + 1; hipLaunchKernelGGL(tab[k], dim3(grid), dim3(NWAVES * 64), LDS_BYTES, stream, a); }
#else
    a.ph_lo = 0; a.ph_hi = NPH; hipLaunchKernelGGL(tab[NPH], dim3(grid), dim3(NWAVES * 64), LDS_BYTES, stream, a);
#endif
}
```

```cpp
#include <hip/hip_runtime.h>
#include <cstdio>
#include <cstdint>
namespace pg8 {
#define PG8_LAS __attribute__((address_space(3)))
typedef unsigned short bf16_t;
typedef short bf16x8 __attribute__((ext_vector_type(8)));
typedef float f32x4 __attribute__((ext_vector_type(4)));
typedef unsigned u32x4 __attribute__((ext_vector_type(4)));
typedef int v4i_ __attribute__((ext_vector_type(4)));
typedef int v8i_ __attribute__((ext_vector_type(8)));
constexpr int BM = 256, BK = 64, HALF = 128, HTB = HALF * BK * 2  , STAGE_BYTES = 8 * HTB, NXCD = 8, WGM = 8;

__host__ __device__ __forceinline__ int lds_byte(int r, int c) { return (r >> 3) * 1024 + (r & 7) * 128 + ((((c >> 3) ^ (r & 7)) & 7) << 4); }
__host__ __device__ __forceinline__ void stage_rc(int b, int& R, int& C) { const int blk = b / 1024, p = b % 1024, rb = p / 128, sl = (p % 128) / 16; R = 8 * blk + rb; C = ((sl ^ rb) & 7) * 8; }
__host__ __device__ __forceinline__ int perm32(int rho) { const int n = rho >> 4, i = rho & 15; return 8 * (i >> 2) + 4 * n + (i & 3); }

struct Unit { int pm, pn; };
struct Gemm { const bf16_t* A; const bf16_t* Bt; int M, N, K; const bf16_t* A2; const bf16_t* Bt2; int sw, sx; };

struct StaticOrder {
    int nM, nN, nwg, G, c;
    __host__ __device__ void init(int M, int N, int G_, int c_) { nM = M / BM; nN = N / BM; nwg = nM * nN; G = G_; c = c_; }
    __host__ __device__ bool next(int i, Unit& u) const {
        const long L = (long)i * G + c; if (L >= nwg) return false;
        int wgid = (int)L; { const int q = nwg / NXCD, r = nwg % NXCD, xcd = wgid % NXCD, off = wgid / NXCD; wgid = (xcd < r ? xcd * (q + 1) : r * (q + 1) + (xcd - r) * q) + off; }
        const int nig = WGM * nN, gid = wgid / nig, fm = gid * WGM, gsz = (nM - fm) < WGM ? (nM - fm) : WGM;
        u.pm = fm + ((wgid % nig) % gsz); u.pn = (wgid % nig) / gsz; return true;
    }
    __device__ __forceinline__ void a_ready(const Unit&) const {}
    __device__ __forceinline__ void done(const Unit&) const {}
};
__device__ __forceinline__ unsigned cvt_pk_bf16(float lo, float hi) { unsigned r; asm volatile("v_cvt_pk_bf16_f32 %0, %1, %2" : "=v"(r) : "v"(lo), "v"(hi)); return r; }
template <class Epi, class Sched, bool ALIGN_EPI = false, bool SP2 = false, bool FP8 = false, bool PAIR = false>
__device__ __forceinline__ void gemm_phase(PG8_LAS unsigned char* lds, const Gemm g, const Sched& S, const Epi& E) {
    const int tid = threadIdx.x, wid = __builtin_amdgcn_readfirstlane(tid >> 6), lane = tid & 63, wr = wid >> 2, wc = wid & 3, fr = lane & 15, fq = lane >> 4;
    const int K = g.K, nt = K / BK;
    unsigned voffA[2], voffB[2];
#pragma unroll
    for (int i = 0; i < 2; ++i) { int R, C; stage_rc(tid * 16 + i * 8192, R, C); const int Rb = Epi::PERM ? ((R & ~31) + perm32(R & 31)) : R;
        voffA[i] = (unsigned)(R * K + C) * 2u; voffB[i] = (unsigned)(Rb * K + C) * 2u; }
    const size_t kstep = (size_t)(BK * 2);
    const size_t hstep = (size_t)HALF * K * 2;
    const size_t tstep = 2 * hstep;
    const unsigned ldsw = (unsigned)wid * 1024u;
    const int aoff0 = lds_byte(wr * 64 + fr, fq * 8), aoff1 = lds_byte(wr * 64 + fr, 32 + fq * 8), boff0 = lds_byte(wc * 32 + fr, fq * 8), boff1 = lds_byte(wc * 32 + fr, 32 + fq * 8);
#define PG8_SA(b, h) (((b) * 2 + (h)) * HTB)
#define PG8_SB(b, h) ((4 + (b) * 2 + (h)) * HTB)
#define PG8_STAGE(bufoff, gbase, voff) do { _Pragma("unroll") for (int _i = 0; _i < 2; ++_i) \
        __builtin_amdgcn_global_load_lds((const unsigned*)((const char*)(gbase) + (voff)[_i]), (PG8_LAS unsigned*)(lds + (bufoff) + ldsw + _i * 8192), 16, 0, 0); } while (0)
#define PG8_LDA(dst, b, h) do { if constexpr (FP8) { _Pragma("unroll") for (int m = 0; m < 4; ++m) { const v4i_ lo_ = *(const PG8_LAS v4i_*)(lds + PG8_SA(b, h) + aoff0 + m * 2048), hi_ = *(const PG8_LAS v4i_*)(lds + PG8_SA(b, h) + aoff1 + m * 2048); dst##8[m] = __builtin_shufflevector(lo_, hi_, 0, 1, 2, 3, 4, 5, 6, 7); } } \
        else { _Pragma("unroll") for (int m = 0; m < 4; ++m) _Pragma("unroll") for (int k = 0; k < 2; ++k) dst[m][k] = *(const PG8_LAS bf16x8*)(lds + PG8_SA(b, h) + (k ? aoff1 : aoff0) + m * 2048); } } while (0)
#define PG8_LDB(dst, b, h) do { if constexpr (FP8) { _Pragma("unroll") for (int n = 0; n < 2; ++n) { const v4i_ lo_ = *(const PG8_LAS v4i_*)(lds + PG8_SB(b, h) + boff0 + n * 2048), hi_ = *(const PG8_LAS v4i_*)(lds + PG8_SB(b, h) + boff1 + n * 2048); dst##8[n] = __builtin_shufflevector(lo_, hi_, 0, 1, 2, 3, 4, 5, 6, 7); } } \
        else { _Pragma("unroll") for (int n = 0; n < 2; ++n) _Pragma("unroll") for (int k = 0; k < 2; ++k) dst[n][k] = *(const PG8_LAS bf16x8*)(lds + PG8_SB(b, h) + (k ? boff1 : boff0) + n * 2048); } } while (0)
#define PG8_MMA(ai, bj, At, Bt) do { \
        if constexpr (FP8) {   \
            _Pragma("unroll") for (int m = 0; m < 4; ++m) asm volatile("" : "+v"(At##8[m])); _Pragma("unroll") for (int n = 0; n < 2; ++n) asm volatile("" : "+v"(Bt##8[n])); } \
        __builtin_amdgcn_s_setprio(1); _Pragma("unroll") for (int m = 0; m < 4; ++m) _Pragma("unroll") for (int n = 0; n < 2; ++n) { \
        if constexpr (FP8) {   \
            acc[ai][bj][m][n] = __builtin_amdgcn_mfma_scale_f32_16x16x128_f8f6f4(Bt##8[n], At##8[m], acc[ai][bj][m][n], 0, 0, 0, g.sw, 0, g.sx); \
        } else { _Pragma("unroll") for (int k = 0; k < 2; ++k) acc[ai][bj][m][n] = __builtin_amdgcn_mfma_f32_16x16x32_bf16(Bt[n][k], At[m][k], acc[ai][bj][m][n], 0, 0, 0); } } \
        if constexpr (FP8) { _Pragma("unroll") for (int m = 0; m < 4; ++m) _Pragma("unroll") for (int n = 0; n < 2; ++n) asm volatile("" : "+v"(acc[ai][bj][m][n])); } \
        __builtin_amdgcn_s_setprio(0); } while (0)
#define PG8_WAIT_V(n) asm volatile("s_waitcnt vmcnt(" #n ")" ::: "memory")
#define PG8_WAIT_L(n) asm volatile("s_waitcnt lgkmcnt(" #n ")" ::: "memory")
#define PG8_BAR __builtin_amdgcn_s_barrier()
#define PG8_SCHED __builtin_amdgcn_sched_barrier(0)
    Unit cur, nxt; int ui = 0;
    if (!S.next(0, cur)) return;
    f32x4 acc[2][2][4][2];
#pragma unroll
    for (int a = 0; a < 2; ++a)
#pragma unroll
        for (int b = 0; b < 2; ++b)
#pragma unroll
            for (int m = 0; m < 4; ++m)
#pragma unroll
                for (int n = 0; n < 2; ++n) acc[a][b][m][n] = (f32x4){0.f, 0.f, 0.f, 0.f};
    bf16x8 At[4][2], B0[2][2], B1[2][2]; v8i_ At8[4], B08[2], B18[2];
    const char* cA = (const char*)g.A + (size_t)cur.pm * tstep; const char* cB = (const char*)g.Bt + (size_t)cur.pn * tstep;
    S.a_ready(cur);
    if constexpr (SP2) {
        PG8_STAGE(PG8_SB(0, 0), cB, voffB); PG8_STAGE(PG8_SB(0, 1), cB + hstep, voffB); PG8_STAGE(PG8_SA(0, 0), cA, voffA); PG8_STAGE(PG8_SA(0, 1), cA + hstep, voffA);
        if (wr == 1) PG8_BAR;
        PG8_WAIT_V(2); PG8_BAR;
        PG8_STAGE(PG8_SB(1, 0), cB + kstep, voffB); PG8_STAGE(PG8_SA(1, 0), cA + kstep, voffA); PG8_STAGE(PG8_SB(1, 1), cB + hstep + kstep, voffB);
        PG8_WAIT_V(6); PG8_BAR;
    } else {
        PG8_STAGE(PG8_SB(0, 0), cB, voffB); PG8_STAGE(PG8_SA(0, 0), cA, voffA); PG8_STAGE(PG8_SB(0, 1), cB + hstep, voffB); PG8_STAGE(PG8_SA(0, 1), cA + hstep, voffA);
        if (wr == 1) PG8_BAR;
        PG8_WAIT_V(4); PG8_BAR;
        PG8_STAGE(PG8_SB(1, 0), cB + kstep, voffB); PG8_STAGE(PG8_SA(1, 0), cA + kstep, voffA); PG8_STAGE(PG8_SB(1, 1), cB + hstep + kstep, voffB);
        PG8_WAIT_V(6); PG8_BAR;
    }
    for (;;) {
        bool has_next;
        if constexpr (PAIR) { if ((ui & 1) == 0) { nxt = cur; has_next = true; } else has_next = S.next((ui + 1) >> 1, nxt); } else has_next = S.next(ui + 1, nxt);
        const char* nAb = (const char*)g.A; const char* nBb = (const char*)g.Bt;
        if constexpr (PAIR) { if ((ui & 1) == 0) { nAb = (const char*)g.A2; nBb = (const char*)g.Bt2; } }
        const char* nA = has_next ? nAb + (size_t)nxt.pm * tstep : cA; const char* nB = has_next ? nBb + (size_t)nxt.pn * tstep : cB;
        for (int t = 0; t < nt; t += 2) {
            const bool last = (t == nt - 2);
            const char* a1 = cA + (size_t)(t + 1) * kstep;
            const char* a2 = last ? nA : cA + (size_t)(t + 2) * kstep; const char* b2 = last ? nB : cB + (size_t)(t + 2) * kstep;
            const char* a3 = a2 + kstep; const char* b3 = b2 + kstep;
            if (last && has_next) S.a_ready(nxt);
            if constexpr (SP2) {
            PG8_LDB(B0, 0, 0); PG8_LDB(B1, 0, 1); PG8_SCHED; PG8_LDA(At, 0, 0); PG8_STAGE(PG8_SA(1, 1), a1 + hstep, voffA);
            PG8_WAIT_V(8); PG8_WAIT_L(0); PG8_BAR; PG8_MMA(0, 0, At, B0); PG8_MMA(0, 1, At, B1); PG8_BAR; PG8_SCHED;
            PG8_LDA(At, 0, 1); PG8_STAGE(PG8_SB(0, 0), b2, voffB); PG8_STAGE(PG8_SB(0, 1), b2 + hstep, voffB); PG8_STAGE(PG8_SA(0, 0), a2, voffA);
            PG8_WAIT_V(8); PG8_WAIT_L(0); PG8_BAR; PG8_MMA(1, 0, At, B0); PG8_MMA(1, 1, At, B1); PG8_BAR; PG8_SCHED;
            PG8_LDB(B0, 1, 0); PG8_LDB(B1, 1, 1); PG8_SCHED; PG8_LDA(At, 1, 0); PG8_STAGE(PG8_SA(0, 1), a2 + hstep, voffA);
            PG8_WAIT_V(8); PG8_WAIT_L(0); PG8_BAR; PG8_MMA(0, 0, At, B0); PG8_MMA(0, 1, At, B1); PG8_BAR; PG8_SCHED;
            PG8_LDA(At, 1, 1); PG8_STAGE(PG8_SB(1, 0), b3, voffB); PG8_STAGE(PG8_SB(1, 1), b3 + hstep, voffB); PG8_STAGE(PG8_SA(1, 0), a3, voffA);
            PG8_WAIT_V(8); PG8_WAIT_L(0); PG8_BAR; PG8_MMA(1, 0, At, B0); PG8_MMA(1, 1, At, B1); PG8_BAR; PG8_SCHED;
            } else {
            PG8_LDB(B0, 0, 0); PG8_SCHED; PG8_LDA(At, 0, 0); PG8_STAGE(PG8_SA(1, 1), a1 + hstep, voffA);
            PG8_WAIT_L(8); PG8_BAR; PG8_WAIT_L(0); PG8_MMA(0, 0, At, B0); PG8_BAR; PG8_SCHED;
            PG8_LDB(B1, 0, 1); PG8_STAGE(PG8_SB(0, 0), b2, voffB);
            PG8_BAR; PG8_WAIT_L(0); PG8_MMA(0, 1, At, B1); PG8_BAR;
            PG8_LDA(At, 0, 1); PG8_STAGE(PG8_SA(0, 0), a2, voffA);
            PG8_BAR; PG8_WAIT_L(0); PG8_MMA(1, 0, At, B0); PG8_BAR; PG8_SCHED;
            PG8_STAGE(PG8_SB(0, 1), b2 + hstep, voffB);
            PG8_WAIT_V(6); PG8_BAR; PG8_MMA(1, 1, At, B1); PG8_BAR;
            PG8_LDB(B0, 1, 0); PG8_SCHED; PG8_LDA(At, 1, 0); PG8_STAGE(PG8_SA(0, 1), a2 + hstep, voffA);
            PG8_WAIT_L(8); PG8_BAR; PG8_WAIT_L(0); PG8_MMA(0, 0, At, B0); PG8_BAR; PG8_SCHED;
            PG8_LDB(B1, 1, 1); PG8_STAGE(PG8_SB(1, 0), b3, voffB);
            PG8_BAR; PG8_WAIT_L(0); PG8_MMA(0, 1, At, B1); PG8_BAR;
            PG8_LDA(At, 1, 1); PG8_STAGE(PG8_SA(1, 0), a3, voffA);
            PG8_BAR; PG8_WAIT_L(0); PG8_MMA(1, 0, At, B0); PG8_BAR; PG8_SCHED;
            PG8_STAGE(PG8_SB(1, 1), b3 + hstep, voffB);
            PG8_WAIT_V(6); PG8_BAR; PG8_MMA(1, 1, At, B1); PG8_BAR;
            }
        }
        if constexpr (ALIGN_EPI) { if (wr == 0) PG8_BAR; }
        if constexpr (PAIR) { if ((ui & 1) == 0) E.mid(acc, cur, wr, wc, fr, fq); else E(acc, cur, wr, wc, fr, fq); }
        else if constexpr (!Epi::AFTER_DRAIN) { E(acc, cur, wr, wc, fr, fq); S.done(cur); }
        if (!has_next) break;
        if (!PAIR || (ui & 1)) {
#pragma unroll
        for (int a = 0; a < 2; ++a)
#pragma unroll
            for (int b = 0; b < 2; ++b)
#pragma unroll
                for (int m = 0; m < 4; ++m)
#pragma unroll
                    for (int n = 0; n < 2; ++n) acc[a][b][m][n] = (f32x4){0.f, 0.f, 0.f, 0.f};
        }
        cur = nxt; cA = nA; cB = nB; ++ui;
        if constexpr (ALIGN_EPI) { if (wr == 1) PG8_BAR; }
    }
    PG8_WAIT_V(0);
    if constexpr (!ALIGN_EPI) { if (wr == 0) PG8_BAR; }
    PG8_BAR;
    if constexpr (Epi::AFTER_DRAIN) { E.fused(acc, cur, wr, wc, fr, fq, lds, wid, lane); S.done(cur); }
#undef PG8_SA
#undef PG8_SB
#undef PG8_STAGE
#undef PG8_LDA
#undef PG8_LDB
#undef PG8_MMA
#undef PG8_WAIT_V
#undef PG8_WAIT_L
#undef PG8_BAR
#undef PG8_SCHED
}
}
#define GAS __attribute__((address_space(1)))
#define LAS __attribute__((address_space(3)))
typedef unsigned short bf16;
typedef unsigned v4u __attribute__((ext_vector_type(4)));
typedef float f32x4 __attribute__((ext_vector_type(4)));
typedef short bf16x8 __attribute__((ext_vector_type(8)));
typedef GAS unsigned gu32;
typedef GAS unsigned long long gu64;
#define RLX_AGENT __ATOMIC_RELAXED, __HIP_MEMORY_SCOPE_AGENT
#define LDS_WAIT() asm volatile("s_waitcnt lgkmcnt(0)" ::: "memory")
#define VM_WAIT() asm volatile("s_waitcnt vmcnt(0)" ::: "memory")
__device__ __forceinline__ unsigned long long rt() { return __builtin_amdgcn_s_memrealtime(); }
__device__ __forceinline__ unsigned f2bf(float f) { unsigned u = __builtin_bit_cast(unsigned, f); return (u + 0x7fffu + ((u >> 16) & 1u)) >> 16; }
__device__ __forceinline__ unsigned pk2(float lo, float hi) { return f2bf(lo) | (f2bf(hi) << 16); }
#define XB_TMO      128
#define XB_XCNT(j)  (256  + 64 * (j))
#define XB_XSUB(j)  (1280 + 64 * (j))
#define XB_XGEN(j)  (2304 + 64 * (j))
#define XB_TOP      3328
#define XB_TOPGEN   3392
#define XCD_BAR_WORDS 3456
#define XB_SPIN_CAP (1u << 18)

__device__ __forceinline__ unsigned xb_ld(unsigned* p)              { return __hip_atomic_load(p, __ATOMIC_RELAXED, __HIP_MEMORY_SCOPE_AGENT); }
__device__ __forceinline__ unsigned xb_add(unsigned* p, unsigned v) { return __hip_atomic_fetch_add(p, v, __ATOMIC_RELAXED, __HIP_MEMORY_SCOPE_AGENT); }
__device__ __forceinline__ unsigned xb_xcc_id() { return (unsigned)__builtin_amdgcn_s_getreg((3 << 11) | 20) & 0xFu; }
#define XB_SPIN(cond, bar) do { unsigned _sp = 0; while (cond) { __builtin_amdgcn_s_sleep(1); \
    if ((++_sp & 255u) == 0u) { if (xb_ld(&(bar)[XB_TMO])) break; if (_sp > XB_SPIN_CAP) { atomicAdd(&(bar)[XB_TMO], 1u); break; } } } } while (0)

struct XcdBarrier {
    unsigned* bar; unsigned x;
    volatile LAS unsigned* st;
};

__device__ __forceinline__ XcdBarrier xcd_barrier_post(unsigned* bar, volatile LAS unsigned* st) {
    XcdBarrier b; b.bar = bar; b.x = xb_xcc_id(); b.st = st;
    if (threadIdx.x == 0) (void)xb_add(&bar[XB_XCNT(b.x)], 1u);
    return b;
}
__device__ __forceinline__ void xcd_barrier_complete(unsigned* bar, unsigned x, unsigned& nloc, unsigned& nx) {
    const unsigned G = gridDim.x * gridDim.y * gridDim.z;
    unsigned sum, cnt, mine, sp = 0u;
    for (;;) {
        sum = 0u; cnt = 0u; mine = 0u;
#pragma unroll
        for (unsigned j = 0; j < 16; ++j) { const unsigned c = xb_ld(&bar[XB_XCNT(j)]); sum += c; cnt += (c > 0u) ? 1u : 0u; mine = (j == x) ? c : mine; }
        if (sum == G) break;
        __builtin_amdgcn_s_sleep(1);
        if ((++sp & 255u) == 0u) { if (xb_ld(&bar[XB_TMO])) break; if (sp > XB_SPIN_CAP) { atomicAdd(&bar[XB_TMO], 1u); break; } }
    }
    nloc = mine > 0u ? mine : 1u; nx = cnt > 0u ? cnt : 1u;
}

__device__ __forceinline__ void xcd_barrier(const XcdBarrier& b) {
    asm volatile("s_waitcnt vmcnt(0)" ::: "memory");
    __syncthreads();
    if (threadIdx.x == 0) {
        unsigned* bar = b.bar;
        __builtin_amdgcn_s_waitcnt(0);
        unsigned nloc = b.st[0], nx = b.st[1];
        if (nloc == 0u) { xcd_barrier_complete(bar, b.x, nloc, nx); b.st[0] = nloc; b.st[1] = nx; }
        const unsigned old = xb_add(&bar[XB_XSUB(b.x)], 1u);
        const unsigned gen = old / nloc;
        if (old + 1u == (gen + 1u) * nloc) {
            __builtin_amdgcn_fence(__ATOMIC_RELEASE, "agent");
            asm volatile("s_waitcnt vmcnt(0)" ::: "memory");
            const unsigned og = xb_add(&bar[XB_TOP], 1u);
            const unsigned tg = og / nx;
            if (og + 1u == (tg + 1u) * nx) xb_add(&bar[XB_TOPGEN], 1u);
            else XB_SPIN(xb_ld(&bar[XB_TOPGEN]) == tg, bar);
            __builtin_amdgcn_fence(__ATOMIC_ACQUIRE, "agent");
            xb_add(&bar[XB_XGEN(b.x)], 1u);
            asm volatile("s_waitcnt vmcnt(0)" ::: "memory");
        } else {
            XB_SPIN(xb_ld(&bar[XB_XGEN(b.x)]) == gen, bar);
            __builtin_amdgcn_fence(__ATOMIC_ACQUIRE, "agent");
            asm volatile("s_waitcnt vmcnt(0)" ::: "memory");
        }
    }
    __syncthreads();
}

constexpr int NWAVES = 8;
constexpr int NTOK = 65536, DM = 1024, SEQ = 2048, NBATCH = 32, INC = 4864;
constexpr int NEXP = 32, TOPK = 4;
constexpr int IN_BF = 2048;
constexpr float NORM_EPS = 1e-5f;
constexpr float LOG2E = 1.4426950408889634f;
constexpr float QSCALE = 0.125f * LOG2E;
constexpr int HALF_TOK = NTOK;
constexpr int HALF_ROWS = NTOK * TOPK + NEXP * 256;

constexpr size_t MiB = 1u << 20;
constexpr size_t WS_CTL = 0, CTL_ZERO_BYTES = 1 * MiB;
constexpr int CW_BAR = 4096;
constexpr size_t WS_WIN = 2 * MiB;
constexpr size_t WS_WIN8 = 8 * MiB;
constexpr size_t WS_WUA = 12 * MiB;
constexpr size_t WS_WUH = 13 * MiB;
constexpr size_t WS_WOUT = 14 * MiB;
constexpr size_t WS_W1 = 184 * MiB;
constexpr size_t WS_W2 = 16 * MiB;
constexpr size_t WS_ROPE = 55 * MiB;
constexpr size_t WS_WRT = 55 * MiB + 512 * 1024;
constexpr size_t WS_TOPE = 48 * MiB;
constexpr size_t WS_GATE = 49 * MiB;
constexpr size_t WS_LRANK = 50 * MiB;
constexpr size_t WS_ROWOF = 51 * MiB;
constexpr size_t WS_RS = 54 * MiB + 512 * 1024;
constexpr size_t WS_CNT = 52 * MiB;
constexpr size_t WS_EST = 52 * MiB + 512 * 1024;
constexpr size_t WS_RSROW = 54 * MiB + 768 * 1024;
constexpr size_t WS_GATEROW = 53 * MiB;
constexpr size_t WS_U = 248 * MiB;
constexpr size_t WS_MX = 56 * MiB;
constexpr size_t WS_Z = 376 * MiB;
constexpr size_t WS_Q = WS_Z;
constexpr size_t WS_KV = WS_Z + 64 * MiB;
constexpr size_t WS_HQ = WS_Z + 96 * MiB;
constexpr size_t WS_HF = WS_Z + 160 * MiB;
constexpr size_t WS_HI = WS_Z + 224 * MiB;
constexpr size_t WS_HG = WS_Z + 288 * MiB;
constexpr size_t WS_GA = WS_Z + 352 * MiB;
constexpr size_t WS_GB = WS_Z + 480 * MiB;
constexpr size_t WS_U8 = WS_MX;
constexpr size_t WS_YH = WS_U;
constexpr size_t WS_AO = WS_U + 64 * MiB;
constexpr size_t WS_Y = 184 * MiB;
constexpr size_t WS_XS = 448 * MiB;
constexpr size_t WS_ACT = 712 * MiB;
constexpr size_t WS_END = WS_Z + 608 * MiB;
static_assert((size_t)HALF_ROWS * 2048 == 528 * MiB && WS_Y + 528 * MiB == WS_ACT && WS_XS + 264 * MiB == WS_ACT && WS_XS >= WS_U + 64 * MiB, "MoE buffers");
static_assert(WS_ACT + 264 * MiB <= WS_END && WS_END <= 1024 * MiB && WS_MX + 128 * MiB <= WS_W1 && WS_W1 + 64 * MiB <= WS_U, "ws map");

constexpr int LDS_BYTES = 147456;
constexpr int RING_BYTES = 131072;
constexpr int MISC_OFF = RING_BYTES + 320;

typedef float f32x16 __attribute__((ext_vector_type(16)));
typedef unsigned u32x2 __attribute__((ext_vector_type(2)));

__device__ __forceinline__ float bf2f(unsigned short v) { return __builtin_bit_cast(float, (unsigned)v << 16); }
__device__ __forceinline__ float bflo(unsigned w) { return __builtin_bit_cast(float, w << 16); }
__device__ __forceinline__ float bfhi(unsigned w) { return __builtin_bit_cast(float, w & 0xffff0000u); }
__device__ __forceinline__ float sigmoidf_(float x) { return 1.f / (1.f + __expf(-x)); }
__device__ __forceinline__ float wave_sum(float v) {
#pragma unroll
    for (int o = 1; o < 64; o <<= 1) v += __shfl_xor(v, o);
    return v;
}

__device__ __forceinline__ unsigned pk4_fp8(float a, float b, float c, float d) {
    int w = 0; w = __builtin_amdgcn_cvt_pk_fp8_f32(a, b, w, false); w = __builtin_amdgcn_cvt_pk_fp8_f32(c, d, w, true); return (unsigned)w; }
__device__ __forceinline__ float clamp448(float v) { return fminf(fmaxf(v, -448.f), 448.f); }
struct Args { const float* in[18]; float* out; unsigned char* ws; int ph_lo, ph_hi; };
struct Frame {
    LAS unsigned char* lds;
    int tid, lane, wave, G;
    float* out;
    unsigned char* ws;
};

using pg8::Unit;

struct EpiInProj {
    static constexpr bool PERM = true, AFTER_DRAIN = false;
    unsigned char* ws; const float* bias; const float* rope; int pn_keep, pn_add;
    __device__ __forceinline__ void operator()(const pg8::f32x4 (&acc)[2][2][4][2], const Unit& u, int wr, int wc, int fr, int fq) const {
        const int pn = u.pn + (u.pn >= pn_keep ? pn_add : 0);
        bf16* dst; int ld, c0;
        if (pn < 2) { dst = (bf16*)(ws + WS_Q); ld = 512; c0 = 256 * pn; }
        else if (pn == 2) { dst = (bf16*)(ws + WS_KV); ld = 256; c0 = 0; }
        else if (pn < 11) { const int k = (pn - 3) >> 1; dst = (bf16*)(ws + WS_HQ + (size_t)k * 64 * MiB); ld = 512; c0 = 256 * ((pn - 3) & 1); }
        else { const int k = (pn - 11) >> 2; dst = (bf16*)(ws + WS_GA + (size_t)k * 128 * MiB); ld = 1024; c0 = 256 * ((pn - 11) & 3); }
        const int row0 = u.pm * 256 + wr * 64 + fr;
#pragma unroll
        for (int bj = 0; bj < 2; ++bj) {
            const int cl = bj * 128 + wc * 32 + 8 * fq;
            const int sc = pn * 256 + cl;
            const bool rp = (pn < 2) || (pn == 2 && bj == 0);
            const int hb = sc & ~63, grp = (sc & 63) >> 3;
            pg8::f32x4 b0, b1;
            if (rp) { b0 = *(const pg8::f32x4*)(bias + hb + grp * 4); b1 = *(const pg8::f32x4*)(bias + hb + 32 + grp * 4); }
            else { b0 = *(const pg8::f32x4*)(bias + sc); b1 = *(const pg8::f32x4*)(bias + sc + 4); }
            const float qs = (pn < 2) ? QSCALE : 1.f;
#pragma unroll
            for (int ai = 0; ai < 2; ++ai)
#pragma unroll
                for (int m = 0; m < 4; ++m) {
                    const int row = row0 + ai * 128 + m * 16;
                    pg8::f32x4 v0 = acc[ai][bj][m][0] + b0, v1 = acc[ai][bj][m][1] + b1;
                    if (rp) {
                        const int pos = row & (SEQ - 1);
                        const pg8::f32x4 cs = *(const pg8::f32x4*)(rope + pos * 32 + grp * 4);
                        const pg8::f32x4 sn = *(const pg8::f32x4*)(rope + SEQ * 32 + pos * 32 + grp * 4);
                        const pg8::f32x4 o0 = (v0 * cs - v1 * sn) * qs, o1 = (v1 * cs + v0 * sn) * qs;
                        v0 = o0; v1 = o1;
                    }
                    pg8::u32x4 w; w.x = pg8::cvt_pk_bf16(v0[0], v0[1]); w.y = pg8::cvt_pk_bf16(v0[2], v0[3]); w.z = pg8::cvt_pk_bf16(v1[0], v1[1]); w.w = pg8::cvt_pk_bf16(v1[2], v1[3]);
                    *(pg8::u32x4*)(dst + (size_t)row * ld + c0 + cl) = w;
                }
        }
    }
};

struct EpiFuse {
    static constexpr bool PERM = true, AFTER_DRAIN = false;
    const bf16* Ga; bf16* Gb; unsigned char* M8;
    __device__ __forceinline__ void mid(pg8::f32x4 (&acc)[2][2][4][2], const Unit& u, int wr, int wc, int fr, int fq) const {
        const int row0 = u.pm * 256 + wr * 64 + fr;
#pragma unroll
        for (int ai = 0; ai < 2; ++ai)
#pragma unroll
            for (int m = 0; m < 4; ++m)
#pragma unroll
                for (int bj = 0; bj < 2; ++bj) {
                    const size_t off = (size_t)(row0 + ai * 128 + m * 16) * 1024 + u.pn * 256 + bj * 128 + wc * 32 + 8 * fq;
                    const pg8::u32x4 av = *(const pg8::u32x4*)(Ga + off), hv = *(const pg8::u32x4*)(Gb + off);
#pragma unroll
                    for (int i = 0; i < 4; ++i) {
                        const float a0 = bflo(av[i]), a1 = bfhi(av[i]), h0 = fmaxf(bflo(hv[i]), -60.f), h1 = fmaxf(bfhi(hv[i]), -60.f);
                        const float r0 = (1.f + __expf(-h0)) * __builtin_amdgcn_rcpf(1.f + __expf(-a0)), r1 = (1.f + __expf(-h1)) * __builtin_amdgcn_rcpf(1.f + __expf(-a1));
                        acc[ai][bj][m][i >> 1][(i & 1) * 2] *= r0; acc[ai][bj][m][i >> 1][(i & 1) * 2 + 1] *= r1;
                    }
                }
    }
    __device__ __forceinline__ void operator()(const pg8::f32x4 (&acc)[2][2][4][2], const Unit& u, int wr, int wc, int fr, int fq) const {
        const int row0 = u.pm * 256 + wr * 64 + fr;
#pragma unroll
        for (int ai = 0; ai < 2; ++ai)
#pragma unroll
            for (int m = 0; m < 4; ++m)
#pragma unroll
                for (int bj = 0; bj < 2; ++bj) {
                    const size_t off = (size_t)(row0 + ai * 128 + m * 16) * 1024 + u.pn * 256 + bj * 128 + wc * 32 + 8 * fq;
                    const pg8::u32x4 hv = *(const pg8::u32x4*)(Gb + off);
                    float o[8];
#pragma unroll
                    for (int i = 0; i < 4; ++i) {
                        const float h0 = fmaxf(bflo(hv[i]), -60.f), h1 = fmaxf(bfhi(hv[i]), -60.f);
                        const pg8::f32x4 a = acc[ai][bj][m][i >> 1];
                        o[2 * i] = a[(i & 1) * 2] * __builtin_amdgcn_rcpf(1.f + __expf(-h0)); o[2 * i + 1] = a[(i & 1) * 2 + 1] * __builtin_amdgcn_rcpf(1.f + __expf(-h1));
                    }
                    u32x2 w; w.x = pk4_fp8(clamp448(8.f * o[0]), clamp448(8.f * o[1]), clamp448(8.f * o[2]), clamp448(8.f * o[3])); w.y = pk4_fp8(clamp448(8.f * o[4]), clamp448(8.f * o[5]), clamp448(8.f * o[6]), clamp448(8.f * o[7]));
                    *(u32x2*)(M8 + off) = w;
                }
    }
};

struct EpiPlain {
    static constexpr bool PERM = true, AFTER_DRAIN = false;
    bf16* O;
    __device__ __forceinline__ void operator()(const pg8::f32x4 (&acc)[2][2][4][2], const Unit& u, int wr, int wc, int fr, int fq) const {
        const int row0 = u.pm * 256 + wr * 64 + fr;
#pragma unroll
        for (int ai = 0; ai < 2; ++ai)
#pragma unroll
            for (int m = 0; m < 4; ++m)
#pragma unroll
                for (int bj = 0; bj < 2; ++bj) {
                    const pg8::f32x4 v0 = acc[ai][bj][m][0], v1 = acc[ai][bj][m][1];
                    pg8::u32x4 w; w.x = pg8::cvt_pk_bf16(v0[0], v0[1]); w.y = pg8::cvt_pk_bf16(v0[2], v0[3]); w.z = pg8::cvt_pk_bf16(v1[0], v1[1]); w.w = pg8::cvt_pk_bf16(v1[2], v1[3]);
                    *(pg8::u32x4*)(O + (size_t)(row0 + ai * 128 + m * 16) * 1024 + u.pn * 256 + bj * 128 + wc * 32 + 8 * fq) = w;
                }
    }
};

struct EpiSwiGlu {
    static constexpr bool PERM = true, AFTER_DRAIN = false;
    unsigned char* act; const float* b1;
    __device__ __forceinline__ void operator()(const pg8::f32x4 (&acc)[2][2][4][2], const Unit& u, int wr, int wc, int fr, int fq) const {
        const int e = u.pn >> 3, ct = u.pn & 7;
        const int j0 = 128 * ct + 32 * wc + 8 * fq;
        const float* bp = b1 + (size_t)e * 2048 + j0;
        const pg8::f32x4 bg0 = *(const pg8::f32x4*)(bp), bg1 = *(const pg8::f32x4*)(bp + 4), bl0 = *(const pg8::f32x4*)(bp + 1024), bl1 = *(const pg8::f32x4*)(bp + 1028);
        const int row0 = u.pm * 256 + wr * 64 + fr;
#pragma unroll
        for (int ai = 0; ai < 2; ++ai)
#pragma unroll
            for (int m = 0; m < 4; ++m) {
                const int row = row0 + ai * 128 + m * 16;
                float o[8];
#pragma unroll
                for (int n = 0; n < 2; ++n) {
                    const pg8::f32x4 g = acc[ai][0][m][n] + (n ? bg1 : bg0), l = acc[ai][1][m][n] + (n ? bl1 : bl0);
#pragma unroll
                    for (int i = 0; i < 4; ++i) {
                        const float gg = fminf(g[i], 7.f), ll = fminf(fmaxf(l[i], -7.f), 7.f);
                        o[4 * n + i] = gg * __builtin_amdgcn_rcpf(1.f + __expf(-1.702f * gg)) * (ll + 1.f);
                    }
                }
                u32x2 w; w.x = pk4_fp8(o[0], o[1], o[2], o[3]); w.y = pk4_fp8(o[4], o[5], o[6], o[7]);
                *(u32x2*)(act + (size_t)row * 1024 + j0) = w;
            }
    }
};

struct EpiMoeOut {
    static constexpr bool PERM = true, AFTER_DRAIN = false;
    unsigned char* y; const float* b2; const float* gaterow;
    __device__ __forceinline__ void operator()(const pg8::f32x4 (&acc)[2][2][4][2], const Unit& u, int wr, int wc, int fr, int fq) const {
        const int e = u.pn >> 2, ct = u.pn & 3;
        const int row0 = u.pm * 256 + wr * 64 + fr;
#pragma unroll
        for (int bj = 0; bj < 2; ++bj) {
            const int col = 256 * ct + 128 * bj + 32 * wc + 8 * fq;
            const pg8::f32x4 b0 = *(const pg8::f32x4*)(b2 + (size_t)e * 1024 + col), bb1 = *(const pg8::f32x4*)(b2 + (size_t)e * 1024 + col + 4);
#pragma unroll
            for (int ai = 0; ai < 2; ++ai)
#pragma unroll
                for (int m = 0; m < 4; ++m) {
                    const int row = row0 + ai * 128 + m * 16;
                    const float gt = 16.f * gaterow[row];
                    const pg8::f32x4 v0 = (acc[ai][bj][m][0] + b0) * gt, v1 = (acc[ai][bj][m][1] + bb1) * gt;
                    u32x2 w; w.x = pk4_fp8(clamp448(v0[0]), clamp448(v0[1]), clamp448(v0[2]), clamp448(v0[3])); w.y = pk4_fp8(clamp448(v1[0]), clamp448(v1[1]), clamp448(v1[2]), clamp448(v1[3]));
                    *(u32x2*)(y + (size_t)row * 1024 + col) = w;
                }
        }
    }
};

struct MoeOrder {
    unsigned pk[16]; int ntiles, sh, c, G;
    __device__ __forceinline__ void init(const int* est, int lane, int nct_shift, int G_, int c_) {
        const int v = est[lane & 63];
        int st[33];
#pragma unroll
        for (int k = 0; k < 33; ++k) st[k] = __builtin_amdgcn_readlane(v, k);
#pragma unroll
        for (int k = 0; k < 16; ++k) pk[k] = (unsigned)st[2 * k] | ((unsigned)st[2 * k + 1] << 16);
        ntiles = st[32]; sh = nct_shift; G = G_; c = (G_ % 8 == 0) ? (c_ % 8) * (G_ / 8) + c_ / 8 : c_;
    }
    __device__ __forceinline__ bool next(int i, Unit& u) const {
        const int uid = i * G + c, rt = uid >> sh, ct = uid & ((1 << sh) - 1);
        if (rt >= ntiles) return false;
        int e = 0;
#pragma unroll
        for (int k = 1; k < 32; ++k) e += (rt >= (int)((pk[k >> 1] >> (16 * (k & 1))) & 0xffffu)) ? 1 : 0;
        u.pm = rt; u.pn = (e << sh) + ct; return true;
    }
    __device__ __forceinline__ void a_ready(const Unit&) const {}
    __device__ __forceinline__ void done(const Unit&) const {}
};

template <class RowMap>
__device__ __forceinline__ void transpose_item(const float* W, int K, int N, bf16* WT, const RowMap& rm, LAS float* scr, int item, int lane) {
    const int nblk = N / 32, kb = item / nblk, nb = item % nblk, k0 = 64 * kb, n0 = 32 * nb;
#pragma unroll 8
    for (int i = 0; i < 32; ++i) { const int kk = 2 * i + (lane >> 5); scr[kk * 33 + (lane & 31)] = W[(size_t)(k0 + kk) * N + n0 + (lane & 31)]; }
    LDS_WAIT(); asm volatile("" ::: "memory");
    const int c = lane & 7;
#pragma unroll
    for (int j = 0; j < 4; ++j) { const int n = (lane >> 3) + 8 * j; const LAS float* s = scr + (8 * c) * 33 + n;
        v4u o; o.x = pk2(s[0 * 33], s[1 * 33]); o.y = pk2(s[2 * 33], s[3 * 33]); o.z = pk2(s[4 * 33], s[5 * 33]); o.w = pk2(s[6 * 33], s[7 * 33]);
        *(GAS v4u*)(WT + (size_t)rm(n0 + n) * K + k0 + 8 * c) = o; }
    LDS_WAIT(); asm volatile("" ::: "memory");
}
template <class RowMap>
__device__ __forceinline__ void transpose_item_f8(const float* W, int K, int N, unsigned char* WT, const RowMap& rm, LAS float* scr, int item, int lane) {
    const int nblk = N / 32, kb = item / nblk, nb = item % nblk, k0 = 64 * kb, n0 = 32 * nb;
#pragma unroll 8
    for (int i = 0; i < 32; ++i) { const int kk = 2 * i + (lane >> 5); scr[kk * 33 + (lane & 31)] = W[(size_t)(k0 + kk) * N + n0 + (lane & 31)]; }
    LDS_WAIT(); asm volatile("" ::: "memory");
    const int c = lane & 7;
#pragma unroll
    for (int j = 0; j < 4; ++j) { const int n = (lane >> 3) + 8 * j; const LAS float* s = scr + (8 * c) * 33 + n;
        u32x2 o; o.x = pk4_fp8(32.f * s[0 * 33], 32.f * s[1 * 33], 32.f * s[2 * 33], 32.f * s[3 * 33]); o.y = pk4_fp8(32.f * s[4 * 33], 32.f * s[5 * 33], 32.f * s[6 * 33], 32.f * s[7 * 33]);
        *(GAS u32x2*)(WT + (size_t)rm(n0 + n) * K + k0 + 8 * c) = o; }
    LDS_WAIT(); asm volatile("" ::: "memory");
}
struct RmId { __device__ __forceinline__ int operator()(int n) const { return n; } };
struct RmIn {
    __device__ __forceinline__ int operator()(int n) const {
        if (n >= 640) return n;
        const int hb = n & ~63, d = n & 63, half = d >> 5, grp = (d & 31) >> 2, j = d & 3;
        return hb + grp * 8 + half * 4 + j;
    }
};
struct RmW1 {
    __device__ __forceinline__ int operator()(int n) const { const int lin = n >> 10, j = n & 1023; return (j >> 7) * 256 + lin * 128 + (j & 127); }
};

__device__ __forceinline__ void p0_prologue(Frame& F, const Args& A) {
    LAS float* scr = (LAS float*)(F.lds + F.wave * 16384);
    const int gw = blockIdx.x * NWAVES + F.wave, NGW = F.G * NWAVES;
    unsigned char* ws = F.ws;
    constexpr int I_IN = 16 * (INC / 32), I_UA = 8 * 32, I_OUT = 16 * 32, I_W1 = 16 * 64, I_W2 = 16 * 32;
    constexpr int NITEMS = I_IN + 2 * I_UA + I_OUT;
    for (int it = gw; it < NITEMS; it += NGW) {
        int r = it;
        if (r < I_IN) { const int nb_ = r % (INC / 32), n0_ = 32 * nb_;
            if (n0_ >= 768 && n0_ < 2816) transpose_item(A.in[2], 1024, INC, (bf16*)(ws + WS_WIN) - (size_t)768 * 1024, RmIn(), scr, r, F.lane);
            else if (n0_ < 768) transpose_item_f8(A.in[2], 1024, INC, ws + WS_WIN8, RmIn(), scr, r, F.lane);
            else transpose_item_f8(A.in[2], 1024, INC, ws + WS_WIN8 - (size_t)2048 * 1024, RmId(), scr, r, F.lane);
            continue; } r -= I_IN;
        if (r < I_UA) { transpose_item(A.in[7], 512, 1024, (bf16*)(ws + WS_WUA), RmId(), scr, r, F.lane); continue; } r -= I_UA;
        if (r < I_UA) { transpose_item(A.in[8], 512, 1024, (bf16*)(ws + WS_WUH), RmId(), scr, r, F.lane); continue; } r -= I_UA;
        transpose_item_f8(A.in[9], 1024, 1024, ws + WS_WOUT, RmId(), scr, r, F.lane);
    }
    const int gt = blockIdx.x * (NWAVES * 64) + F.tid, NGT = F.G * NWAVES * 64;
    { bf16* wh = (bf16*)(ws + WS_WRT); bf16* wl = wh + 32 * 1024;
      for (int i = gt; i < 32 * 1024; i += NGT) { const int e = i >> 10, k = i & 1023; const float v = A.in[10][k] * A.in[11][k * 32 + e];
          const unsigned h = f2bf(v); const float r = v - bf2f((unsigned short)h); wh[i] = (bf16)h; wl[i] = (bf16)f2bf(r); } }
    { float* rc = (float*)(ws + WS_ROPE); float* rsn = rc + SEQ * 32;
      for (int i = gt; i < SEQ * 32; i += NGT) { const int pos = i >> 5, j = i & 31;
          const float inv = (float)pow(10000.0, -(double)j / 32.0); const float ang = (float)pos * inv;
          rc[i] = (float)cos((double)ang); rsn[i] = (float)sin((double)ang); } }
    { const float* x = A.in[0]; const float* g = A.in[1]; bf16* U = (bf16*)(ws + WS_U);
      f32x4 gv[4];
#pragma unroll
      for (int j = 0; j < 4; ++j) gv[j] = *(const f32x4*)(g + 256 * j + 4 * F.lane);
      for (int m0 = gw * 4; m0 < NTOK; m0 += NGW * 4) {
          f32x4 v[4][4]; float s[4];
#pragma unroll
          for (int r = 0; r < 4; ++r) { const GAS f32x4* xr = (const GAS f32x4*)(x + (size_t)(m0 + r) * DM) + F.lane;
#pragma unroll
              for (int j = 0; j < 4; ++j) v[r][j] = __builtin_nontemporal_load((const f32x4*)(x + (size_t)(m0 + r) * DM) + F.lane + 64 * j); }
#pragma unroll
          for (int r = 0; r < 4; ++r) { float t = 0.f;
#pragma unroll
              for (int j = 0; j < 4; ++j) t += (v[r][j].x * v[r][j].x + v[r][j].y * v[r][j].y) + (v[r][j].z * v[r][j].z + v[r][j].w * v[r][j].w);
              s[r] = t; }
#pragma unroll
          for (int o = 1; o < 64; o <<= 1) {
#pragma unroll
              for (int r = 0; r < 4; ++r) s[r] += __shfl_xor(s[r], o); }
#pragma unroll
          for (int r = 0; r < 4; ++r) { const float rs = rsqrtf(s[r] * (1.f / DM) + NORM_EPS);
              GAS unsigned long long* o8 = (GAS unsigned long long*)(U + (size_t)(m0 + r) * DM) + F.lane;
#pragma unroll
              for (int j = 0; j < 4; ++j) { const f32x4 t = v[r][j] * rs * gv[j]; o8[64 * j] = (unsigned long long)pk2(t.x, t.y) | ((unsigned long long)pk2(t.z, t.w) << 32);
                  *(GAS unsigned*)(ws + WS_U8 + (size_t)(m0 + r) * DM + 256 * j + 4 * F.lane) = pk4_fp8(clamp448(t.x), clamp448(t.y), clamp448(t.z), clamp448(t.w)); } }
      } }
}

constexpr int WP_I1 = 32 * 8, WP_I2 = 32 * 4, WP_NIT = NEXP * (WP_I1 + WP_I2);
constexpr int WP_SPLIT = (WP_NIT * 6 / 10) / 2048 * 2048;
__device__ __forceinline__ void moe_weight_prep(Frame& F, const Args& A, int wg0, int nwg, int it0, int it1) {
    unsigned char* ws = F.ws;
    const int lane = F.lane;
    const int gw = ((int)blockIdx.x - wg0) * NWAVES + F.wave, NGW = nwg * NWAVES;
    for (int it = it0 + gw; it < it1; it += NGW) {
        const bool isw1 = it < NEXP * WP_I1;
        const int r = isw1 ? it : it - NEXP * WP_I1;
        const int per = isw1 ? WP_I1 : WP_I2, e = r / per, rr = r % per, kb = rr & 31, nb = rr >> 5, N = isw1 ? 2048 : 1024;
        const float* W = (isw1 ? A.in[13] + (size_t)e * 1024 * 2048 : A.in[15] + (size_t)e * 1024 * 1024) + (size_t)(32 * kb) * N + 256 * nb + 4 * lane;
        f32x4 v[32];
#pragma unroll
        for (int j = 0; j < 32; ++j) v[j] = __builtin_nontemporal_load((const f32x4*)(W + (size_t)j * N));
        unsigned char* WT = isw1 ? ws + WS_W1 + (size_t)e * 2048 * 1024 : ws + WS_W2 + (size_t)e * 1024 * 1024;
#pragma unroll
        for (int c = 0; c < 4; ++c) { const int n = 256 * nb + 4 * lane + c; const int drow = isw1 ? RmW1()(n) : n;
            v4u o0, o1;
#pragma unroll
            for (int q = 0; q < 4; ++q) { o0[q] = pk4_fp8(32.f * v[4 * q][c], 32.f * v[4 * q + 1][c], 32.f * v[4 * q + 2][c], 32.f * v[4 * q + 3][c]);
                                          o1[q] = pk4_fp8(32.f * v[16 + 4 * q][c], 32.f * v[16 + 4 * q + 1][c], 32.f * v[16 + 4 * q + 2][c], 32.f * v[16 + 4 * q + 3][c]); }
            *(GAS v4u*)(WT + (size_t)drow * 1024 + 32 * kb) = o0; *(GAS v4u*)(WT + (size_t)drow * 1024 + 32 * kb + 16) = o1; }
    }
}

typedef short s16x4 __attribute__((ext_vector_type(4)));
typedef short v4i16_t __attribute__((ext_vector_type(4)));
__device__ __forceinline__ s16x4 ldtr(const LAS unsigned char* p) { return __builtin_bit_cast(s16x4, __builtin_amdgcn_ds_read_tr16_b64_v4i16((LAS v4i16_t*)p)); }
typedef float f32x2_t __attribute__((ext_vector_type(2))); typedef __bf16 bf16x2_t __attribute__((ext_vector_type(2)));
__device__ __forceinline__ unsigned cvtpk(float lo, float hi) { f32x2_t v = {lo, hi}; bf16x2_t b = __builtin_convertvector(v, bf16x2_t); return __builtin_bit_cast(unsigned, b); }
__device__ __forceinline__ void attn_phase(Frame& F, const Args& A, int wg0, int nwg) {
    const bf16* Q = (const bf16*)(F.ws + WS_Q); const bf16* KV = (const bf16*)(F.ws + WS_KV); bf16* AO = (bf16*)(F.ws + WS_AO);
    const float* sinks = A.in[4];
    const int lane = F.lane, r32 = lane & 31, hi = lane >> 5;
    LAS unsigned char* vs = F.lds + F.wave * 8192;
    const LAS unsigned char* vp = vs + ((lane >> 4) & 1) * 32 + (lane & 3) * 8 + (4 * hi + ((lane & 15) >> 2)) * 64;
    LAS unsigned char* qs = F.lds + 65536 + F.wave * 8192 + lane * 16;
    const int gw = ((int)blockIdx.x - wg0) * NWAVES + F.wave, NGW = nwg * NWAVES;
    constexpr int NUNITS = NBATCH * 2 * 2 * 64;
#define AT_DEC(u_, b_, kvh_, h_, q0_) do { b_ = (u_) >> 8; const int rem_ = (u_) & 255; kvh_ = rem_ >> 7; h_ = kvh_ * 4 + 2 * ((rem_ >> 6) & 1); q0_ = (rem_ & 63) * 32; } while (0)
#define AT_TF(q0_) ((((q0_) - 127) >> 6) < 0 ? 0 : (((q0_) - 127) >> 6))
#define AT_LOADK(KF, b_, kvh_, key0_) do { const bf16* kp_ = KV + ((size_t)(b_) * SEQ + (key0_) + r32) * 256 + (kvh_) * 64 + hi * 8; \
        _Pragma("unroll") for (int d0 = 0; d0 < 4; ++d0) { KF[2 * d0] = *(const bf16x8*)(kp_ + d0 * 16); KF[2 * d0 + 1] = *(const bf16x8*)(kp_ + 32 * 256 + d0 * 16); } } while (0)
#define AT_LOADV(VV, b_, kvh_, key0_) do { \
        _Pragma("unroll") for (int p = 0; p < 8; ++p) VV[p] = *(const v4u*)(KV + ((size_t)(b_) * SEQ + (key0_) + 16 * (p & 3) + (lane >> 2)) * 256 + 128 + (kvh_) * 64 + 32 * (p >> 2) + 8 * (lane & 3)); } while (0)
#define AT_LOADQ(HD, b_, h_, q0_) do { _Pragma("unroll") for (int d0 = 0; d0 < 4; ++d0) *(LAS bf16x8*)(qs + ((HD) * 4 + d0) * 1024) = *(const bf16x8*)(Q + ((size_t)(b_) * SEQ + (q0_) + r32) * 512 + (h_) * 64 + d0 * 16 + hi * 8); } while (0)
#define AT_Q(HD, d0) (*(const LAS bf16x8*)(qs + ((HD) * 4 + (d0)) * 1024))
#define AT_HEAD(HD, M_, L_, O0, O1) do { \
        f32x16 p0, p1; \
        _Pragma("unroll") for (int r = 0; r < 16; ++r) { p0[r] = 0.f; p1[r] = 0.f; } \
        _Pragma("unroll") for (int d0 = 0; d0 < 4; ++d0) { const bf16x8 qf = AT_Q(HD, d0); p0 = __builtin_amdgcn_mfma_f32_32x32x16_bf16(kfN[2 * d0], qf, p0, 0, 0, 0); p1 = __builtin_amdgcn_mfma_f32_32x32x16_bf16(kfN[2 * d0 + 1], qf, p1, 0, 0, 0); } \
        float mx = -INFINITY; \
        if (edge) { const int dq = q - key0 - 4 * hi; _Pragma("unroll") for (int r = 0; r < 16; ++r) { const int c_ = (r & 3) + 8 * (r >> 2); \
            if ((unsigned)(dq - c_) > 127u) p0[r] = -INFINITY; \
            if ((unsigned)(dq - c_ - 32) > 127u) p1[r] = -INFINITY; } } \
        _Pragma("unroll") for (int r = 0; r < 16; ++r) mx = fmaxf(mx, fmaxf(p0[r], p1[r])); \
        mx = fmaxf(mx, __shfl_xor(mx, 32)); \
        const float mn = fmaxf(M_, mx), al = __builtin_amdgcn_exp2f(M_ - mn); M_ = mn; \
        float sum = 0.f; \
        _Pragma("unroll") for (int r = 0; r < 16; ++r) { p0[r] = __builtin_amdgcn_exp2f(p0[r] - mn); p1[r] = __builtin_amdgcn_exp2f(p1[r] - mn); sum += p0[r] + p1[r]; O0[r] *= al; O1[r] *= al; } \
        L_ = L_ * al + sum; \
        bf16x8 pa[4]; \
        _Pragma("unroll") for (int ks = 0; ks < 4; ++ks) { v4u w; \
            _Pragma("unroll") for (int i = 0; i < 4; ++i) w[i] = (ks < 2) ? cvtpk(p0[8 * (ks & 1) + 2 * i], p0[8 * (ks & 1) + 2 * i + 1]) : cvtpk(p1[8 * (ks & 1) + 2 * i], p1[8 * (ks & 1) + 2 * i + 1]); \
            pa[ks] = __builtin_bit_cast(bf16x8, w); } \
        _Pragma("unroll") for (int ks = 0; ks < 4; ++ks) { \
            const s16x4 a0 = ldtr(vp + ks * 1024), a1 = ldtr(vp + ks * 1024 + 512), c0 = ldtr(vp + 4096 + ks * 1024), c1 = ldtr(vp + 4096 + ks * 1024 + 512); \
            const bf16x8 v0 = {a0[0], a0[1], a0[2], a0[3], a1[0], a1[1], a1[2], a1[3]}, v1 = {c0[0], c0[1], c0[2], c0[3], c1[0], c1[1], c1[2], c1[3]}; \
            O0 = __builtin_amdgcn_mfma_f32_32x32x16_bf16(v0, pa[ks], O0, 0, 0, 0); \
            O1 = __builtin_amdgcn_mfma_f32_32x32x16_bf16(v1, pa[ks], O1, 0, 0, 0); } } while (0)
#define AT_STORE(H_, L_, O0, O1) do { const float lt = L_ + __shfl_xor(L_, 32), il = 1.f / lt; \
        bf16* op = AO + ((size_t)b * SEQ + q) * 512 + (H_) * 64 + 4 * hi; \
        _Pragma("unroll") for (int rg = 0; rg < 4; ++rg) { u32x2 w0, w1; \
            w0.x = cvtpk(O0[4 * rg] * il, O0[4 * rg + 1] * il); w0.y = cvtpk(O0[4 * rg + 2] * il, O0[4 * rg + 3] * il); \
            w1.x = cvtpk(O1[4 * rg] * il, O1[4 * rg + 1] * il); w1.y = cvtpk(O1[4 * rg + 2] * il, O1[4 * rg + 3] * il); \
            *(u32x2*)(op + 8 * rg) = w0; *(u32x2*)(op + 32 + 8 * rg) = w1; } } while (0)
    int u = gw;
    if (u >= NUNITS) return;
    int b, kvh, h, q0; AT_DEC(u, b, kvh, h, q0);
    int t = AT_TF(q0);
    bf16x8 kfN[8]; v4u vvN[8];
    AT_LOADK(kfN, b, kvh, 64 * t); AT_LOADV(vvN, b, kvh, 64 * t);
    bool first = true;
    float ma = 0.f, la = 0.f, mb = 0.f, lb = 0.f; f32x16 oa0, oa1, ob0, ob1;
#pragma unroll
    for (int r = 0; r < 16; ++r) { oa0[r] = 0.f; oa1[r] = 0.f; ob0[r] = 0.f; ob1[r] = 0.f; }
    for (;;) {
        const int tlast = (q0 + 31) >> 6, q = q0 + r32, key0 = 64 * t;
        const bool lastt = (t == tlast);
        const bool edge = lastt || (key0 + 127 < q0 + 31);
        if (first) {
            AT_LOADQ(0, b, h, q0); AT_LOADQ(1, b, h + 1, q0);
            ma = sinks[h] * LOG2E; mb = sinks[h + 1] * LOG2E; la = hi ? 0.f : 1.f; lb = la;
#pragma unroll
            for (int r = 0; r < 16; ++r) { oa0[r] = 0.f; oa1[r] = 0.f; ob0[r] = 0.f; ob1[r] = 0.f; }
            first = false;
        }
#pragma unroll
        for (int p = 0; p < 8; ++p) *(LAS v4u*)(vs + p * 1024 + lane * 16) = vvN[p];
        int un = lastt ? u + NGW : u, bn = b, kvhn = kvh, hn = h, q0n = q0;
        const bool more = un < NUNITS;
        int tn = t + 1;
        if (more && lastt) { AT_DEC(un, bn, kvhn, hn, q0n); tn = AT_TF(q0n); }
        if (more) AT_LOADV(vvN, bn, kvhn, 64 * tn);
        AT_HEAD(0, ma, la, oa0, oa1);
        {
            f32x16 p0, p1;
#pragma unroll
            for (int r = 0; r < 16; ++r) { p0[r] = 0.f; p1[r] = 0.f; }
#pragma unroll
            for (int d0 = 0; d0 < 4; ++d0) { const bf16x8 qf = AT_Q(1, d0); p0 = __builtin_amdgcn_mfma_f32_32x32x16_bf16(kfN[2 * d0], qf, p0, 0, 0, 0); p1 = __builtin_amdgcn_mfma_f32_32x32x16_bf16(kfN[2 * d0 + 1], qf, p1, 0, 0, 0); }
            asm volatile("" : "+v"(p0), "+v"(p1));
            if (more) AT_LOADK(kfN, bn, kvhn, 64 * tn);
            float mx = -INFINITY;
            if (edge) { const int dq = q - key0 - 4 * hi;
#pragma unroll
                for (int r = 0; r < 16; ++r) { const int c_ = (r & 3) + 8 * (r >> 2);
                    if ((unsigned)(dq - c_) > 127u) p0[r] = -INFINITY;
                    if ((unsigned)(dq - c_ - 32) > 127u) p1[r] = -INFINITY; } }
#pragma unroll
            for (int r = 0; r < 16; ++r) mx = fmaxf(mx, fmaxf(p0[r], p1[r]));
            mx = fmaxf(mx, __shfl_xor(mx, 32));
            const float mn = fmaxf(mb, mx), al = __builtin_amdgcn_exp2f(mb - mn); mb = mn;
            float sum = 0.f;
#pragma unroll
            for (int r = 0; r < 16; ++r) { p0[r] = __builtin_amdgcn_exp2f(p0[r] - mn); p1[r] = __builtin_amdgcn_exp2f(p1[r] - mn); sum += p0[r] + p1[r]; ob0[r] *= al; ob1[r] *= al; }
            lb = lb * al + sum;
            bf16x8 pa[4];
#pragma unroll
            for (int ks = 0; ks < 4; ++ks) { v4u w;
#pragma unroll
                for (int i = 0; i < 4; ++i) w[i] = (ks < 2) ? cvtpk(p0[8 * (ks & 1) + 2 * i], p0[8 * (ks & 1) + 2 * i + 1]) : cvtpk(p1[8 * (ks & 1) + 2 * i], p1[8 * (ks & 1) + 2 * i + 1]);
                pa[ks] = __builtin_bit_cast(bf16x8, w); }
#pragma unroll
            for (int ks = 0; ks < 4; ++ks) {
                const s16x4 a0 = ldtr(vp + ks * 1024), a1 = ldtr(vp + ks * 1024 + 512), c0 = ldtr(vp + 4096 + ks * 1024), c1 = ldtr(vp + 4096 + ks * 1024 + 512);
                const bf16x8 v0 = {a0[0], a0[1], a0[2], a0[3], a1[0], a1[1], a1[2], a1[3]}, v1 = {c0[0], c0[1], c0[2], c0[3], c1[0], c1[1], c1[2], c1[3]};
                ob0 = __builtin_amdgcn_mfma_f32_32x32x16_bf16(v0, pa[ks], ob0, 0, 0, 0);
                ob1 = __builtin_amdgcn_mfma_f32_32x32x16_bf16(v1, pa[ks], ob1, 0, 0, 0);
            }
        }
        if (lastt) {
            AT_STORE(h, la, oa0, oa1); AT_STORE(h + 1, lb, ob0, ob1);
            if (!more) break;
            u = un; b = bn; kvh = kvhn; h = hn; q0 = q0n; t = tn; first = true;
        } else { t = tn; }
    }
#undef AT_DEC
#undef AT_TF
#undef AT_LOADK
#undef AT_LOADV
#undef AT_LOADQ
#undef AT_Q
#undef AT_HEAD
#undef AT_STORE
}

__device__ __forceinline__ pg8::f32x4 mfma16(bf16x8 a, bf16x8 b, pg8::f32x4 c) { return __builtin_amdgcn_mfma_f32_16x16x32_bf16(a, b, c, 0, 0, 0); }
constexpr int HS_Q = 272, HS_V = 288;
constexpr int HL_QP = 0, HL_KP = 32 * HS_Q, HL_KPP = 2 * 32 * HS_Q, HL_VV = HL_KPP + 32 * HS_V, HL_EREF = HL_VV + 32 * HS_V, HL_DEC = HL_EREF + 512, HL_GSUM = HL_DEC + 512, HL_SSQ = HL_GSUM + 4096;
__device__ __forceinline__ float fsig(float x) { return __builtin_amdgcn_rcpf(1.f + __expf(-x)); }
struct HgStage { unsigned rf[4], rq[4]; v4u rv; u32x2 h0, h1; };
__device__ __forceinline__ void hgrn_phase(Frame& F, const Args& A, int wg0, int nwg) {
    const bf16* HQ = (const bf16*)(F.ws + WS_HQ); const bf16* HFp = (const bf16*)(F.ws + WS_HF); const bf16* HI = (const bf16*)(F.ws + WS_HI); const bf16* HG = (const bf16*)(F.ws + WS_HG);
    bf16* YH = (bf16*)(F.ws + WS_YH);
    LAS unsigned char* L = F.lds;
    const int w = F.wave, lane = F.lane, g = lane >> 4, c16 = lane & 15, qd = c16 >> 2, pd = c16 & 3;
    const int cp = F.tid & 63, tq = F.tid >> 6, tv = F.tid >> 4, cv = F.tid & 15;
    for (int unit = (int)blockIdx.x - wg0; unit < 128; unit += nwg) {
        const int b = unit >> 2, hh = unit & 3; const size_t T0 = (size_t)b * SEQ;
        float lb0, lb1;
        { const float a00 = A.in[5][hh * 128 + 2 * cp], a01 = A.in[5][hh * 128 + 2 * cp + 1], a10 = A.in[5][512 + hh * 128 + 2 * cp], a11 = A.in[5][512 + hh * 128 + 2 * cp + 1];
          lb0 = 1.f / (1.f + __expf(a10 - a00)); lb1 = 1.f / (1.f + __expf(a11 - a01)); }
        const pg8::f32x4 gn = *(const pg8::f32x4*)(A.in[6] + hh * 128 + 16 * w + 4 * g);
        pg8::f32x4 st[8];
#pragma unroll
        for (int i = 0; i < 8; ++i) st[i] = (pg8::f32x4){0.f, 0.f, 0.f, 0.f};
#define HG_LOAD(S, cc) do { const size_t r0_ = T0 + 32 * (size_t)(cc); \
            _Pragma("unroll") for (int i = 0; i < 4; ++i) { const size_t off = (r0_ + 4 * tq + i) * 512 + hh * 128 + 2 * cp; S.rf[i] = __builtin_nontemporal_load((const unsigned*)(HFp + off)); S.rq[i] = __builtin_nontemporal_load((const unsigned*)(HQ + off)); } \
            S.rv = __builtin_nontemporal_load((const v4u*)(HI + (r0_ + tv) * 512 + hh * 128 + cv * 8)); \
            { const size_t o_ = (r0_ + c16) * 512 + hh * 128 + 16 * w + 4 * g; S.h0 = __builtin_nontemporal_load((const u32x2*)(HG + o_)); S.h1 = __builtin_nontemporal_load((const u32x2*)(HG + o_ + 16 * 512)); } } while (0)
#define HG_FIN(prow0) do { float t0 = 0.f, t1 = 0.f; \
              _Pragma("unroll") for (int ww = 0; ww < 8; ++ww) { t0 += ((const LAS float*)(L + HL_SSQ))[ww * 32 + c16]; t1 += ((const LAS float*)(L + HL_SSQ))[ww * 32 + 16 + c16]; } \
              const float r0 = rsqrtf(t0 * (1.f / 128.f) + NORM_EPS), r1 = rsqrtf(t1 * (1.f / 128.f) + NORM_EPS); \
              const size_t off0 = ((prow0) + c16) * 512 + hh * 128 + 16 * w + 4 * g, off1 = off0 + 16 * 512; \
              const float ha[4] = {bflo(pg0.x), bfhi(pg0.x), bflo(pg0.y), bfhi(pg0.y)}, hb[4] = {bflo(pg1.x), bfhi(pg1.x), bflo(pg1.y), bfhi(pg1.y)}; \
              float ya[4], yb[4]; \
              _Pragma("unroll") for (int r = 0; r < 4; ++r) { ya[r] = po0[r] * r0 * gn[r] * ha[r] * fsig(ha[r]); yb[r] = po1[r] * r1 * gn[r] * hb[r] * fsig(hb[r]); } \
              u32x2 wa, wb; wa.x = cvtpk(ya[0], ya[1]); wa.y = cvtpk(ya[2], ya[3]); wb.x = cvtpk(yb[0], yb[1]); wb.y = cvtpk(yb[2], yb[3]); \
              *(u32x2*)(YH + off0) = wa; *(u32x2*)(YH + off1) = wb; } while (0)
#define HG_STEP(S, cc) do { const size_t row0 = T0 + 32 * (size_t)(cc); \
            float cs0[4], cs1[4], kk0[4], kk1[4], qv0[4], qv1[4]; \
            { float s0 = 0.f, s1 = 0.f; \
              _Pragma("unroll") for (int i = 0; i < 4; ++i) { const float f0 = lb0 + (1.f - lb0) * fsig(bflo(S.rf[i])), f1 = lb1 + (1.f - lb1) * fsig(bfhi(S.rf[i])); \
                  s0 += __builtin_amdgcn_logf(f0) * 0.69314718056f; s1 += __builtin_amdgcn_logf(f1) * 0.69314718056f; cs0[i] = s0; cs1[i] = s1; kk0[i] = 1.f - f0; kk1[i] = 1.f - f1; qv0[i] = bflo(S.rq[i]); qv1[i] = bfhi(S.rq[i]); } \
              *(LAS f32x2_t*)(L + HL_GSUM + (tq * 128 + 2 * cp) * 4) = (f32x2_t){s0, s1}; } \
            __syncthreads();                                                                      \
            if ((cc) > 0) HG_FIN(row0 - 32); \
            { float gA[8], gB[8]; \
              _Pragma("unroll") for (int t_ = 0; t_ < 8; ++t_) { const f32x2_t gg = *(const LAS f32x2_t*)(L + HL_GSUM + (t_ * 128 + 2 * cp) * 4); gA[t_] = gg[0]; gB[t_] = gg[1]; } \
              float preA = 0.f, preB = 0.f; \
              _Pragma("unroll") for (int t_ = 0; t_ < 8; ++t_) if (t_ < tq) { preA += gA[t_]; preB += gB[t_]; } \
              const float g01A = (gA[0] + gA[1]) + (gA[2] + gA[3]), g01B = (gB[0] + gB[1]) + (gB[2] + gB[3]); \
              const float hiA = (gA[4] + gA[5]) + (gA[6] + gA[7]), hiB = (gB[4] + gB[5]) + (gB[6] + gB[7]); \
              const float glA = g01A + hiA, glB = g01B + hiB, c01A = __expf(-hiA), c01B = __expf(-hiB); \
              _Pragma("unroll") for (int i = 0; i < 4; ++i) { const float GA_ = preA + cs0[i], GB_ = preB + cs1[i]; const int t = 4 * tq + i; \
                  const float k2a = kk0[i] * __expf(glA - GA_), k2b = kk1[i] * __expf(glB - GB_); \
                  *(LAS unsigned*)(L + HL_QP + t * HS_Q + cp * 4) = cvtpk(qv0[i] * __expf(GA_ - g01A), qv1[i] * __expf(GB_ - g01B)); \
                  *(LAS unsigned*)(L + HL_KP + t * HS_Q + cp * 4) = cvtpk(k2a * c01A, k2b * c01B); \
                  *(LAS unsigned*)(L + HL_KPP + t * HS_V + cp * 4) = cvtpk(k2a, k2b); } \
              if (tq == 0) { *(LAS f32x2_t*)(L + HL_EREF + cp * 8) = (f32x2_t){__expf(g01A), __expf(g01B)}; *(LAS f32x2_t*)(L + HL_DEC + cp * 8) = (f32x2_t){__expf(glA), __expf(glB)}; } \
              *(LAS v4u*)(L + HL_VV + tv * HS_V + cv * 16) = S.rv; } \
            __syncthreads();                                                                      \
            pg8::f32x4 d00 = {0.f, 0.f, 0.f, 0.f}, d01 = d00, d11 = d00; \
            _Pragma("unroll") for (int k4 = 0; k4 < 4; ++k4) { \
                const bf16x8 ka0 = *(const LAS bf16x8*)(L + HL_KP + c16 * HS_Q + (32 * k4 + 8 * g) * 2), ka1 = *(const LAS bf16x8*)(L + HL_KP + (16 + c16) * HS_Q + (32 * k4 + 8 * g) * 2); \
                const bf16x8 qb0 = *(const LAS bf16x8*)(L + HL_QP + c16 * HS_Q + (32 * k4 + 8 * g) * 2), qb1 = *(const LAS bf16x8*)(L + HL_QP + (16 + c16) * HS_Q + (32 * k4 + 8 * g) * 2); \
                d00 = mfma16(ka0, qb0, d00); d01 = mfma16(ka0, qb1, d01); d11 = mfma16(ka1, qb1, d11); } \
            _Pragma("unroll") for (int r = 0; r < 4; ++r) if (4 * g + r > c16) { d00[r] = 0.f; d11[r] = 0.f; } \
            bf16x8 am0, am1; \
            { v4u t0; t0.x = cvtpk(d00[0], d00[1]); t0.y = cvtpk(d00[2], d00[3]); t0.z = 0u; t0.w = 0u; am0 = __builtin_bit_cast(bf16x8, t0); \
              v4u t1; t1.x = cvtpk(d01[0], d01[1]); t1.y = cvtpk(d01[2], d01[3]); t1.z = cvtpk(d11[0], d11[1]); t1.w = cvtpk(d11[2], d11[3]); am1 = __builtin_bit_cast(bf16x8, t1); } \
            bf16x8 vfr; \
            { const s16x4 x0 = ldtr(L + HL_VV + (4 * g + qd) * HS_V + (16 * w + 4 * pd) * 2), x1 = ldtr(L + HL_VV + (16 + 4 * g + qd) * HS_V + (16 * w + 4 * pd) * 2); \
              vfr = (bf16x8){x0[0], x0[1], x0[2], x0[3], x1[0], x1[1], x1[2], x1[3]}; } \
            pg8::f32x4 o0 = {0.f, 0.f, 0.f, 0.f}, o1 = o0; \
            _Pragma("unroll") for (int k4 = 0; k4 < 4; ++k4) { \
                const pg8::f32x4 e0 = *(const LAS pg8::f32x4*)(L + HL_EREF + (32 * k4 + 4 * g) * 4), e1 = *(const LAS pg8::f32x4*)(L + HL_EREF + (32 * k4 + 16 + 4 * g) * 4); \
                const pg8::f32x4 s0 = st[2 * k4] * e0, s1 = st[2 * k4 + 1] * e1; \
                v4u sw; sw.x = cvtpk(s0[0], s0[1]); sw.y = cvtpk(s0[2], s0[3]); sw.z = cvtpk(s1[0], s1[1]); sw.w = cvtpk(s1[2], s1[3]); \
                const bf16x8 sa = __builtin_bit_cast(bf16x8, sw); \
                const u32x2 qa0 = *(const LAS u32x2*)(L + HL_QP + c16 * HS_Q + (32 * k4 + 4 * g) * 2), qa1 = *(const LAS u32x2*)(L + HL_QP + c16 * HS_Q + (32 * k4 + 16 + 4 * g) * 2); \
                const u32x2 qc0 = *(const LAS u32x2*)(L + HL_QP + (16 + c16) * HS_Q + (32 * k4 + 4 * g) * 2), qc1 = *(const LAS u32x2*)(L + HL_QP + (16 + c16) * HS_Q + (32 * k4 + 16 + 4 * g) * 2); \
                const v4u qw0 = {qa0.x, qa0.y, qa1.x, qa1.y}, qw1 = {qc0.x, qc0.y, qc1.x, qc1.y}; \
                o0 = mfma16(sa, __builtin_bit_cast(bf16x8, qw0), o0); o1 = mfma16(sa, __builtin_bit_cast(bf16x8, qw1), o1); } \
            o0 = mfma16(vfr, am0, o0); o1 = mfma16(vfr, am1, o1); \
            _Pragma("unroll") for (int i = 0; i < 8; ++i) { \
                const s16x4 x0 = ldtr(L + HL_KPP + (4 * g + qd) * HS_V + (16 * i + 4 * pd) * 2), x1 = ldtr(L + HL_KPP + (16 + 4 * g + qd) * HS_V + (16 * i + 4 * pd) * 2); \
                const bf16x8 kfr = {x0[0], x0[1], x0[2], x0[3], x1[0], x1[1], x1[2], x1[3]}; \
                const pg8::f32x4 dc = *(const LAS pg8::f32x4*)(L + HL_DEC + (16 * i + 4 * g) * 4); \
                st[i] = mfma16(kfr, vfr, st[i] * dc); } \
            { float s0 = o0[0] * o0[0] + o0[1] * o0[1] + o0[2] * o0[2] + o0[3] * o0[3], s1 = o1[0] * o1[0] + o1[1] * o1[1] + o1[2] * o1[2] + o1[3] * o1[3]; \
              s0 += __shfl_xor(s0, 16); s0 += __shfl_xor(s0, 32); s1 += __shfl_xor(s1, 16); s1 += __shfl_xor(s1, 32); \
              if (g == 0) { ((LAS float*)(L + HL_SSQ))[w * 32 + c16] = s0; ((LAS float*)(L + HL_SSQ))[w * 32 + 16 + c16] = s1; } } \
            po0 = o0; po1 = o1; pg0 = S.h0; pg1 = S.h1; } while (0)
        HgStage sA, sB; pg8::f32x4 po0 = {0.f, 0.f, 0.f, 0.f}, po1 = po0; u32x2 pg0 = {0u, 0u}, pg1 = pg0;
        HG_LOAD(sA, 0); HG_LOAD(sB, 1);
        for (int c = 0; c < SEQ / 32; c += 2) {
            HG_STEP(sA, c);
            if (c + 2 < SEQ / 32) HG_LOAD(sA, c + 2);
            HG_STEP(sB, c + 1);
            if (c + 3 < SEQ / 32) HG_LOAD(sB, c + 3);
        }
        __syncthreads();
        HG_FIN(T0 + SEQ - 32);
#undef HG_LOAD
#undef HG_FIN
#undef HG_STEP
        __syncthreads();
    }
}

__device__ __forceinline__ void attn_naive(Frame& F, const Args& A, int wg0, int nwg) {
    bf16* Q = (bf16*)(F.ws + WS_Q); const bf16* KV = (const bf16*)(F.ws + WS_KV);
    const float* sinks = A.in[4];
    const int gt = (blockIdx.x - wg0) * (NWAVES * 64) + F.tid, NGT = nwg * NWAVES * 64;
    for (int idx = gt; idx < NTOK * 8; idx += NGT) {
        const int h = idx & 7, tok = idx >> 3, t = tok & (SEQ - 1), kvh = h >> 2;
        float q[64], o[64];
        { const v4u* qp = (const v4u*)(Q + (size_t)tok * 512 + h * 64);
#pragma unroll
          for (int c = 0; c < 8; ++c) { const v4u w = qp[c];
#pragma unroll
              for (int i = 0; i < 4; ++i) { q[8 * c + 2 * i] = bflo(w[i]); q[8 * c + 2 * i + 1] = bfhi(w[i]); } } }
#pragma unroll
        for (int d = 0; d < 64; ++d) o[d] = 0.f;
        float m = sinks[h] * LOG2E, l = 1.f;
        const int j0 = (t >= 127) ? t - 127 : 0;
        for (int j = j0; j <= t; ++j) {
            const size_t krow = (size_t)(tok - t + j) * 256;
            const v4u* kp = (const v4u*)(KV + krow + kvh * 64);
            float s = 0.f;
#pragma unroll
            for (int c = 0; c < 8; ++c) { const v4u w = kp[c];
#pragma unroll
                for (int i = 0; i < 4; ++i) { s += q[8 * c + 2 * i] * bflo(w[i]); s += q[8 * c + 2 * i + 1] * bfhi(w[i]); } }
            const float mn = fmaxf(m, s), al = exp2f(m - mn), p = exp2f(s - mn);
            l = l * al + p; m = mn;
            const v4u* vp = (const v4u*)(KV + krow + 128 + kvh * 64);
#pragma unroll
            for (int c = 0; c < 8; ++c) { const v4u w = vp[c];
#pragma unroll
                for (int i = 0; i < 4; ++i) { o[8 * c + 2 * i] = o[8 * c + 2 * i] * al + p * bflo(w[i]); o[8 * c + 2 * i + 1] = o[8 * c + 2 * i + 1] * al + p * bfhi(w[i]); } }
        }
        const float il = 1.f / l;
        v4u* op = (v4u*)((bf16*)(F.ws + WS_AO) + (size_t)tok * 512 + h * 64);
#pragma unroll
        for (int c = 0; c < 8; ++c) { v4u w;
#pragma unroll
            for (int i = 0; i < 4; ++i) w[i] = pk2(o[8 * c + 2 * i] * il, o[8 * c + 2 * i + 1] * il);
            op[c] = w; }
    }
}

__device__ __forceinline__ void hgrn_naive(Frame& F, const Args& A, int wg0, int nwg) {
    bf16* HQ = (bf16*)(F.ws + WS_HQ); const bf16* HFp = (const bf16*)(F.ws + WS_HF); const bf16* HI = (const bf16*)(F.ws + WS_HI); const bf16* HG = (const bf16*)(F.ws + WS_HG);
    const int gi = F.tid >> 7, n = F.tid & 127;
    LAS float* lf = (LAS float*)(F.lds) + gi * 512;
    LAS float* lq = lf + 128; LAS float* red = lf + 256;
    for (int unit = (blockIdx.x - wg0) * 4 + gi; unit < 128 + 3; unit += nwg * 4) {
        const bool act = unit < 128;
        if ((unit - gi) >= 128) break;
        const int b = act ? unit >> 2 : 0, hh = act ? unit & 3 : 0;
        const int ch = hh * 128 + n;
        const float a0 = A.in[5][ch], a1 = A.in[5][512 + ch];
        const float lb = 1.f / (1.f + __expf(a1 - a0));
        const float gn = A.in[6][ch];
        float S[128];
#pragma unroll
        for (int k = 0; k < 128; ++k) S[k] = 0.f;
        for (int t = 0; t < SEQ; ++t) {
            const size_t off = (size_t)(b * SEQ + t) * 512 + ch;
            const float f = lb + (1.f - lb) * sigmoidf_(bf2f(HFp[off]));
            lf[n] = f; lq[n] = bf2f(HQ[off]);
            const float v = bf2f(HI[off]);
            __syncthreads();
            float o = 0.f;
#pragma unroll
            for (int k = 0; k < 128; ++k) { const float fk = lf[k]; S[k] = fk * S[k] + (1.f - fk) * v; o += lq[k] * S[k]; }
            const float ss = wave_sum(o * o);
            if (F.lane == 0) red[(n >> 6)] = ss;
            __syncthreads();
            const float tot = red[0] + red[1];
            const float y = o * rsqrtf(tot * (1.f / 128.f) + NORM_EPS) * gn;
            const float hg = bf2f(HG[off]);
            if (act) ((bf16*)(F.ws + WS_YH))[off] = (bf16)f2bf(y * hg * sigmoidf_(hg));
        }
    }
}

__device__ __forceinline__ float wave_max(float v) {
#pragma unroll
    for (int o = 1; o < 64; o <<= 1) v = fmaxf(v, __shfl_xor(v, o));
    return v;
}
__device__ __forceinline__ void m0_router(Frame& F, const Args& A) {
    unsigned char* ws = F.ws;
    const float* xin = A.in[0]; const bf16* MX = (const bf16*)(ws + WS_MX); bf16* HB = (bf16*)(ws + WS_MX); unsigned char* U2F = ws + WS_U; const float* gffn = A.in[10];
    int* TOPE = (int*)(ws + WS_TOPE); float* GATE = (float*)(ws + WS_GATE); int* LRANK = (int*)(ws + WS_LRANK); int* CNT = (int*)(ws + WS_CNT);
    LAS float* WL = (LAS float*)(F.lds);
    LAS int* hist = (LAS int*)(F.lds + RING_BYTES);
    const int lane = F.lane;
    __syncthreads();
    for (int idx = F.tid; idx < 1024 * 32; idx += NWAVES * 64) { const int k = idx >> 5, e = idx & 31; const int l = (k & 255) >> 2, j = k >> 8, i = k & 3;
        WL[((((j * 4 + i) * 8 + (e >> 2)) * 64 + l) << 2) + (e & 3)] = gffn[k] * A.in[11][idx]; }
    f32x4 gv[4];
#pragma unroll
    for (int j = 0; j < 4; ++j) gv[j] = *(const f32x4*)(gffn + 256 * j + 4 * lane);
    const float brt = A.in[12][lane >> 1];
    __syncthreads();
    for (int seg = blockIdx.x; seg < NTOK / 256; seg += F.G) {
        if (F.tid < 32) hist[F.tid] = 0;
        __syncthreads();
        for (int it = 0; it < 16; ++it) {
            const int tok0 = seg * 256 + F.wave * 32 + 2 * it;
            f32x4 h[2][4]; float ssq[2];
#pragma unroll
            for (int r = 0; r < 2; ++r) { float s = 0.f;
#pragma unroll
                for (int j = 0; j < 4; ++j) { const size_t off = (size_t)(tok0 + r) * DM + 256 * j + 4 * lane;
                    const f32x4 xv = __builtin_nontemporal_load((const f32x4*)(xin + off)); const u32x2 mw = __builtin_nontemporal_load((const u32x2*)(MX + off));
                    h[r][j] = (f32x4){xv.x + bflo(mw.x), xv.y + bfhi(mw.x), xv.z + bflo(mw.y), xv.w + bfhi(mw.y)};
                    s += (h[r][j].x * h[r][j].x + h[r][j].y * h[r][j].y) + (h[r][j].z * h[r][j].z + h[r][j].w * h[r][j].w);
                    { u32x2 hw; hw.x = pk2(h[r][j].x, h[r][j].y); hw.y = pk2(h[r][j].z, h[r][j].w); *(u32x2*)(HB + off) = hw; } }
                ssq[r] = wave_sum(s); }
            const float rs0 = rsqrtf(ssq[0] * (1.f / DM) + NORM_EPS), rs1 = rsqrtf(ssq[1] * (1.f / DM) + NORM_EPS);
#pragma unroll
            for (int j = 0; j < 4; ++j) { const f32x4 t0 = h[0][j] * gv[j] * rs0, t1 = h[1][j] * gv[j] * rs1;
                *(unsigned*)(U2F + (size_t)tok0 * 1024 + 256 * j + 4 * lane) = pk4_fp8(clamp448(t0.x), clamp448(t0.y), clamp448(t0.z), clamp448(t0.w));
                *(unsigned*)(U2F + (size_t)(tok0 + 1) * 1024 + 256 * j + 4 * lane) = pk4_fp8(clamp448(t1.x), clamp448(t1.y), clamp448(t1.z), clamp448(t1.w)); }
            float acc[2][32];
#pragma unroll
            for (int e = 0; e < 32; ++e) { acc[0][e] = 0.f; acc[1][e] = 0.f; }
#pragma unroll 1
            for (int j = 0; j < 4; ++j) {
                const LAS float* wj = WL + ((j * 32 * 64 + lane) << 2);
#pragma unroll
                for (int i = 0; i < 4; ++i) { const float h0 = h[0][0][i], h1 = h[1][0][i];
#pragma unroll
                    for (int eg = 0; eg < 8; ++eg) { const f32x4 wv = *(const LAS f32x4*)(wj + (((i * 8 + eg) * 64) << 2));
#pragma unroll
                        for (int c = 0; c < 4; ++c) { acc[0][4 * eg + c] += h0 * wv[c]; acc[1][4 * eg + c] += h1 * wv[c]; } } }
                h[0][0] = h[0][1]; h[0][1] = h[0][2]; h[0][2] = h[0][3]; h[1][0] = h[1][1]; h[1][1] = h[1][2]; h[1][2] = h[1][3];
            }
#pragma unroll
            for (int r = 0; r < 2; ++r) {
                float v16[16], v8[8], v4[4], v2[2], v1;
#pragma unroll
                for (int i = 0; i < 16; ++i) { const float a = acc[r][i], bb = acc[r][i + 16]; const bool up = (lane & 32) != 0; const float keep = up ? bb : a, send = up ? a : bb; v16[i] = keep + __shfl_xor(send, 32); }
#pragma unroll
                for (int i = 0; i < 8; ++i) { const float a = v16[i], bb = v16[i + 8]; const bool up = (lane & 16) != 0; const float keep = up ? bb : a, send = up ? a : bb; v8[i] = keep + __shfl_xor(send, 16); }
#pragma unroll
                for (int i = 0; i < 4; ++i) { const float a = v8[i], bb = v8[i + 4]; const bool up = (lane & 8) != 0; const float keep = up ? bb : a, send = up ? a : bb; v4[i] = keep + __shfl_xor(send, 8); }
#pragma unroll
                for (int i = 0; i < 2; ++i) { const float a = v4[i], bb = v4[i + 2]; const bool up = (lane & 4) != 0; const float keep = up ? bb : a, send = up ? a : bb; v2[i] = keep + __shfl_xor(send, 4); }
                { const float a = v2[0], bb = v2[1]; const bool up = (lane & 2) != 0; const float keep = up ? bb : a, send = up ? a : bb; v1 = keep + __shfl_xor(send, 2); }
                v1 += __shfl_xor(v1, 1);
                float lg = v1 * (r ? rs1 : rs0) + brt;
                float tv[4]; int te[4];
#pragma unroll
                for (int k = 0; k < 4; ++k) { const float mxv = wave_max(lg); const unsigned long long bal = __ballot(lg == mxv); const int ln = __ffsll((long long)bal) - 1;
                    tv[k] = mxv; te[k] = ln >> 1; if ((lane >> 1) == te[k]) lg = -INFINITY; }
                const int tok = tok0 + r;
                const float e1 = __expf(tv[1] - tv[0]), e2 = __expf(tv[2] - tv[0]), e3 = __expf(tv[3] - tv[0]), inv = 1.f / (1.f + e1 + e2 + e3);
                if (lane == 0) {
                    const int l0 = atomicAdd((int*)&hist[te[0]], 1), l1 = atomicAdd((int*)&hist[te[1]], 1), l2 = atomicAdd((int*)&hist[te[2]], 1), l3 = atomicAdd((int*)&hist[te[3]], 1);
                    *(int4*)(TOPE + tok * 4) = make_int4(te[0], te[1], te[2], te[3]);
                    *(float4*)(GATE + tok * 4) = make_float4(inv, e1 * inv, e2 * inv, e3 * inv);
                    *(int4*)(LRANK + tok * 4) = make_int4(l0, l1, l2, l3);
                }
            }
        }
        __syncthreads();
        if (F.tid < 32) CNT[seg * 32 + F.tid] = hist[F.tid];
        __syncthreads();
    }
}

__device__ __forceinline__ void m1_dispatch(Frame& F, int p) {
    unsigned char* ws = F.ws;
    const int* TOPE = (const int*)(ws + WS_TOPE); const float* GATE = (const float*)(ws + WS_GATE); const int* LRANK = (const int*)(ws + WS_LRANK);
    const int* CNT = (const int*)(ws + WS_CNT); int* EST = (int*)(ws + WS_EST); int* ROWOF = (int*)(ws + WS_ROWOF);
    float* GATEROW = (float*)(ws + WS_GATEROW);
    const unsigned char* U2F = ws + WS_U; unsigned char* XS = ws + WS_XS;
    LAS int* cum = (LAS int*)(F.lds); LAS int* part = cum + 8192; LAS int* tot = part + 512; LAS int* tst = tot + 32;
    __syncthreads();
    for (int i = F.tid; i < 8192; i += NWAVES * 64) cum[i] = CNT[i];
    __syncthreads();
    { const int e = F.tid & 31, pt = F.tid >> 5; int s = 0;
      for (int j = 0; j < 16; ++j) { const int idx = (16 * pt + j) * 32 + e; const int t = cum[idx]; cum[idx] = s; s += t; }
      part[pt * 32 + e] = s; }
    __syncthreads();
    { const int e = F.tid & 31, pt = F.tid >> 5; int off = 0;
      for (int q = 0; q < pt; ++q) off += part[q * 32 + e];
      for (int j = 0; j < 16; ++j) cum[(16 * pt + j) * 32 + e] += off;
      if (pt == 15) tot[e] = off + part[15 * 32 + e]; }
    __syncthreads();
    if (F.tid == 0) { int a = 0; for (int e = 0; e < 32; ++e) { tst[e] = a; a += (tot[e] + 255) >> 8; } tst[32] = a; }
    __syncthreads();
    if (blockIdx.x == 0 && F.tid < 64) EST[p * 64 + F.tid] = (F.tid <= 32) ? tst[F.tid] : 0;
    for (int e = blockIdx.x; e < 32; e += F.G) {
        const int r0 = 256 * tst[e] + tot[e], r1 = 256 * tst[e + 1];
        for (int r = r0 + F.tid; r < r1; r += NWAVES * 64) GATEROW[r] = 0.f;
    }
    const int gw = blockIdx.x * NWAVES + F.wave, NGW = F.G * NWAVES;
    for (int tok0 = 4 * gw; tok0 < NTOK; tok0 += 4 * NGW) {
        int row = 0;
        if (F.lane < 16) {
            const int ai = tok0 * 4 + F.lane, tok = tok0 + (F.lane >> 2);
            const int e = TOPE[ai];
            row = 256 * tst[e] + cum[(tok >> 8) * 32 + e] + LRANK[ai];
            ROWOF[ai] = row; GATEROW[row] = GATE[ai];
        }
        v4u o[4];
#pragma unroll
        for (int i = 0; i < 4; ++i) o[i] = *(const v4u*)(U2F + (size_t)(tok0 + i) * 1024 + F.lane * 16);
#pragma unroll
        for (int i = 0; i < 4; ++i)
#pragma unroll
            for (int k = 0; k < 4; ++k) { const int rk = __builtin_amdgcn_readlane(row, 4 * i + k); *(v4u*)(XS + (size_t)rk * 1024 + F.lane * 16) = o[i]; }
    }
}

__device__ __forceinline__ void m4_combine(Frame& F, const Args& A, int p) {
    unsigned char* ws = F.ws;
    const int* ROWOF = (const int*)(ws + WS_ROWOF); const unsigned char* Y = ws + WS_Y; const float* gf = A.in[17]; const float* xin = A.in[0]; const bf16* MX = (const bf16*)(ws + WS_MX);
    const int gw = blockIdx.x * NWAVES + F.wave, NGW = F.G * NWAVES;
    f32x4 gv[4];
#pragma unroll
    for (int j = 0; j < 4; ++j) gv[j] = *(const f32x4*)(gf + 256 * j + 4 * F.lane);
    for (int tok = p * HALF_TOK + gw; tok < (p + 1) * HALF_TOK; tok += NGW) {
        const int rv = ROWOF[tok * 4 + (F.lane & 3)];
        int rk[4];
#pragma unroll
        for (int k = 0; k < 4; ++k) rk[k] = __builtin_amdgcn_readlane(rv, k);
        float* hp = F.out + (size_t)tok * DM + 4 * F.lane;
        f32x4 v[4]; float s = 0.f;
#pragma unroll
        for (int j = 0; j < 4; ++j) {
            { const u32x2 mw = __builtin_nontemporal_load((const u32x2*)(MX + (size_t)tok * DM + 4 * F.lane + 256 * j)); v[j] = (f32x4){bflo(mw.x), bfhi(mw.x), bflo(mw.y), bfhi(mw.y)}; }
#pragma unroll
            for (int k = 0; k < 4; ++k) { const unsigned w = __builtin_nontemporal_load((const unsigned*)(Y + (size_t)rk[k] * 1024 + 256 * j + 4 * F.lane));
                const f32x2_t lo = __builtin_amdgcn_cvt_pk_f32_fp8((int)w, false), hi2 = __builtin_amdgcn_cvt_pk_f32_fp8((int)w, true);
                v[j].x += lo[0] * 0.0625f; v[j].y += lo[1] * 0.0625f; v[j].z += hi2[0] * 0.0625f; v[j].w += hi2[1] * 0.0625f; }
            s += (v[j].x * v[j].x + v[j].y * v[j].y) + (v[j].z * v[j].z + v[j].w * v[j].w);
        }
        const float rs = rsqrtf(wave_sum(s) * (1.f / DM) + NORM_EPS);
#pragma unroll
        for (int j = 0; j < 4; ++j) __builtin_nontemporal_store(v[j] * rs * gv[j], (f32x4*)(hp + 256 * j));
    }
}

constexpr int NPH = 11;
template <unsigned MASK> __global__ void __launch_bounds__(NWAVES * 64, 2) mega_fwd(Args args) {
    extern __shared__ __attribute__((aligned(16))) unsigned char lds[];
    Frame F;
    F.lds = (LAS unsigned char*)lds;
    F.tid = threadIdx.x; F.lane = F.tid & 63; F.wave = __builtin_amdgcn_readfirstlane(F.tid >> 6); F.G = gridDim.x;
    F.out = args.out; F.ws = args.ws;
    unsigned char* ws = args.ws;
    volatile LAS unsigned* MISC = (volatile LAS unsigned*)(F.lds + MISC_OFF);
    for (int u = F.tid; u < (LDS_BYTES - RING_BYTES) / 4; u += NWAVES * 64) ((LAS unsigned*)(F.lds + RING_BYTES))[u] = 0u;
    __syncthreads();
    const int lo = args.ph_lo, hi = args.ph_hi;
    XcdBarrier bar; bar.bar = (unsigned*)(ws + WS_CTL) + CW_BAR; bar.x = 0; bar.st = nullptr;
    if (hi - lo > 1) bar = xcd_barrier_post((unsigned*)(ws + WS_CTL) + CW_BAR, MISC + 8);
#ifndef DUP_ATTN
#define DUP_ATTN 1
#endif
#ifndef DUP_HGRN
#define DUP_HGRN 1
#endif
#ifndef DUP_MASK
#define DUP_MASK 0u
#endif
#define REPS(k) (((DUP_MASK >> (k)) & 1u) ? 2 : 1)
#define HAS(k) ((MASK >> (k)) & 1u)
#define IN(k) (lo <= (k) && (k) < hi)
#define SEAM(k) do { if (IN(k) && IN((k) + 1)) xcd_barrier(bar); } while (0)

    if (HAS(0) && IN(0)) { for (int rep = 0; rep < REPS(0); ++rep) { p0_prologue(F, args); moe_weight_prep(F, args, 0, F.G, 0, WP_SPLIT); } } SEAM(0);

    if (HAS(1) && IN(1)) {
        {
            pg8::Gemm g{(const pg8::bf16_t*)(ws + WS_U), (const pg8::bf16_t*)(ws + WS_WIN), NTOK, IN_BF, 1024, nullptr, nullptr, 0x7a7a7a7a, 0x7f7f7f7f};
            pg8::StaticOrder S; S.init(NTOK, IN_BF, F.G, (int)blockIdx.x);
            EpiInProj E{ws, args.in[3], (const float*)(ws + WS_ROPE), 0, 3};
            pg8::gemm_phase<EpiInProj, pg8::StaticOrder, true, true>(F.lds, g, S, E);
        }
        {
            pg8::Gemm g{(const pg8::bf16_t*)(ws + WS_U8), (const pg8::bf16_t*)(ws + WS_WIN8), NTOK, INC - IN_BF, 512, nullptr, nullptr, 0x7a7a7a7a, 0x7f7f7f7f};
            pg8::StaticOrder S; S.init(NTOK, INC - IN_BF, F.G, (int)blockIdx.x);
            EpiInProj E{ws, args.in[3], (const float*)(ws + WS_ROPE), 3, 8};
            pg8::gemm_phase<EpiInProj, pg8::StaticOrder, true, true, true>(F.lds, g, S, E);
        }
    } SEAM(1);

    if (HAS(2) && IN(2)) for (int rep = 0; rep < REPS(2); ++rep) {
        const int half = F.G / 2;
        #if defined(NAIVE_ATTN)
        if ((int)blockIdx.x >= half) attn_naive(F, args, half, F.G - half);
#else
        if ((int)blockIdx.x >= half) { for (int r2 = 0; r2 < DUP_ATTN; ++r2) { attn_phase(F, args, half, F.G - half); moe_weight_prep(F, args, half, F.G - half, WP_SPLIT, WP_NIT); } }
#endif
#if defined(NAIVE_HGRN)
        if ((int)blockIdx.x < half) hgrn_naive(F, args, 0, half);
#else
        if ((int)blockIdx.x < half) for (int r2 = 0; r2 < DUP_HGRN; ++r2) hgrn_phase(F, args, 0, half);
#endif
    } SEAM(2);

    if (HAS(3) && IN(3)) {
        pg8::Gemm g{(const pg8::bf16_t*)(ws + WS_AO), (const pg8::bf16_t*)(ws + WS_WUA), NTOK, 1024, 512, (const pg8::bf16_t*)(ws + WS_YH), (const pg8::bf16_t*)(ws + WS_WUH), 0x7a7a7a7a, 0x7f7f7f7f};
        pg8::StaticOrder S; S.init(NTOK, 1024, F.G, (int)blockIdx.x);
        EpiFuse E{(const bf16*)(ws + WS_GA), (bf16*)(ws + WS_GB), ws + WS_HQ};
        pg8::gemm_phase<EpiFuse, pg8::StaticOrder, true, true, false, true>(F.lds, g, S, E);
    } SEAM(3);
    if (HAS(5) && IN(5)) for (int rep = 0; rep < REPS(5); ++rep) {
        pg8::Gemm g{(const pg8::bf16_t*)(ws + WS_HQ), (const pg8::bf16_t*)(ws + WS_WOUT), NTOK, 1024, 512, nullptr, nullptr, 0x7a7a7a7a, 0x7c7c7c7c};
        pg8::StaticOrder S; S.init(NTOK, 1024, F.G, (int)blockIdx.x);
        EpiPlain E{(bf16*)(ws + WS_MX)};
        pg8::gemm_phase<EpiPlain, pg8::StaticOrder, true, true, true>(F.lds, g, S, E);
    } SEAM(5);

    if (HAS(6) && IN(6)) { for (int rep = 0; rep < REPS(6); ++rep) m0_router(F, args); } SEAM(6);

    {
        const int p = 0;
        asm volatile("" : "+s"(ws), "+v"(F.tid), "+v"(F.lane)); F.ws = ws; { float* o_ = F.out; asm volatile("" : "+s"(o_)); F.out = o_; }
        if (HAS(7) && IN(7)) { for (int rep = 0; rep < REPS(7); ++rep) m1_dispatch(F, p); } SEAM(7);
        if (HAS(8) && IN(8)) {
            pg8::Gemm g{(const pg8::bf16_t*)(ws + WS_XS), (const pg8::bf16_t*)(ws + WS_W1), HALF_ROWS, 2048, 512, nullptr, nullptr, 0x7a7a7a7a, 0x7f7f7f7f};
            MoeOrder S; S.init((const int*)(ws + WS_EST), F.lane, 3, F.G, (int)blockIdx.x);
            EpiSwiGlu E{ws + WS_ACT, args.in[14]};
            pg8::gemm_phase<EpiSwiGlu, MoeOrder, true, true, true>(F.lds, g, S, E);
        } SEAM(8);
        if (HAS(9) && IN(9)) {
            pg8::Gemm g{(const pg8::bf16_t*)(ws + WS_ACT), (const pg8::bf16_t*)(ws + WS_W2), HALF_ROWS, 1024, 512, nullptr, nullptr, 0x7a7a7a7a, 0x7f7f7f7f};
            MoeOrder S; S.init((const int*)(ws + WS_EST), F.lane, 2, F.G, (int)blockIdx.x);
            EpiMoeOut E{ws + WS_Y, args.in[16], (const float*)(ws + WS_GATEROW)};
            pg8::gemm_phase<EpiMoeOut, MoeOrder, true, true, true>(F.lds, g, S, E);
        } SEAM(9);
        if (HAS(10) && IN(10)) { m4_combine(F, args, p); }
    }
#undef IN
#undef SEAM
}

#ifndef MK_SPLIT
#define MK_SPLIT 0
#endif
constexpr unsigned MASK_ALL = (1u << NPH) - 1u;
typedef void (*kern_t)(Args);
template <int K> struct PhaseTab { static void fill(kern_t* t) { t[K] = mega_fwd<(1u << K)>; PhaseTab<K - 1>::fill(t); } };
template <> struct PhaseTab<-1> { static void fill(kern_t*) {} };
extern "C" void kernel_launch(void* const* d_in, const int* in_sizes, int n_in, void* d_out, int out_size, void* d_ws, size_t ws_size, hipStream_t stream) {
    static int grid = 0;
    static kern_t tab[NPH + 1];
    if (grid == 0) {
        if (n_in != 18 || out_size != NTOK * DM || ws_size < WS_END) { fprintf(stderr, "kernel_launch: unexpected shapes (n_in %d out %d ws %zu)\n", n_in, out_size, ws_size); grid = -1; return; }
        int dev = 0, cus = 0, per_cu = 0;
        if (hipGetDevice(&dev) != hipSuccess || hipDeviceGetAttribute(&cus, hipDeviceAttributeMultiprocessorCount, dev) != hipSuccess) { grid = -1; return; }
#if MK_SPLIT
        PhaseTab<NPH - 1>::fill(tab);
        for (int k = 0; k < NPH; ++k)
            if (hipFuncSetAttribute((const void*)tab[k], hipFuncAttributeMaxDynamicSharedMemorySize, LDS_BYTES) != hipSuccess) { fprintf(stderr, "kernel_launch: hipFuncSetAttribute failed\n"); grid = -1; return; }
#else
        tab[NPH] = mega_fwd<MASK_ALL>;
        if (hipFuncSetAttribute((const void*)tab[NPH], hipFuncAttributeMaxDynamicSharedMemorySize, LDS_BYTES) != hipSuccess) { fprintf(stderr, "kernel_launch: hipFuncSetAttribute failed\n"); grid = -1; return; }
        if (hipOccupancyMaxActiveBlocksPerMultiprocessor(&per_cu, (const void*)tab[NPH], NWAVES * 64, LDS_BYTES) != hipSuccess || per_cu < 1) { fprintf(stderr, "kernel_launch: occupancy query says %d\n", per_cu); }
#endif
        (void)hipGetLastError();
        grid = cus;
        if (grid > 256) grid = 256;
    }
    if (grid < 0) return;
    (void)hipMemsetAsync((char*)d_ws + WS_CTL, 0, CTL_ZERO_BYTES, stream);
    Args a{};
    for (int i = 0; i < 18; ++i) a.in[i] = (const float*)d_in[i];
    a.out = (float*)d_out; a.ws = (unsigned char*)d_ws;
#if MK_SPLIT
    for (int k = 0; k < NPH; ++k) { a.ph_lo = k; a.ph_hi = k + 1; hipLaunchKernelGGL(tab[k], dim3(grid), dim3(NWAVES * 64), LDS_BYTES, stream, a); }
#else
    a.ph_lo = 0; a.ph_hi = NPH; hipLaunchKernelGGL(tab[NPH], dim3(grid), dim3(NWAVES * 64), LDS_BYTES, stream, a);
#endif
}
```
